# Optimizing an MI355X kernel written in HIP

```python
import math
import jax, jax.numpy as jnp
from jax import lax
import numpy as np


D_MODEL = 2048
BATCH = 2
SEQ = 16384
DEPTH = 1

MEM_TOKENS = 256
GLA_HEADS = 4
GLA_DK = D_MODEL // 8
GLA_DV = D_MODEL // 4
GLA_GATE_RANK = 16
GLA_GATE_TEMP = 16.0
GLA_CHUNK = 64
DSA_HEADS = 8
DSA_HEAD_DIM = D_MODEL // 16
IDX_HEADS = 16
IDX_DIM = D_MODEL // 32
DSA_TOPK_MAX = 256
Q_BLOCK = 128
MEM_HEADS = 4
MEM_HEAD_DIM = D_MODEL // 8
D_FF = 4 * D_MODEL
N_BRANCH = 3
LN_EPS = 1e-5
RMS_EPS = 1e-6
DEEPNORM_ALPHA = (2 * DEPTH) ** 0.25
DEEPNORM_BETA = (8 * DEPTH) ** -0.25

PARTITION = (
    ('gla_q', GLA_HEADS * GLA_DK),
    ('gla_k', GLA_HEADS * GLA_DK),
    ('gla_v', GLA_HEADS * GLA_DV),
    ('gla_r', GLA_HEADS * GLA_DV),
    ('gla_gate_lr', GLA_GATE_RANK),
    ('dsa_q', DSA_HEADS * DSA_HEAD_DIM),
    ('dsa_k', DSA_HEADS * DSA_HEAD_DIM),
    ('dsa_v', DSA_HEADS * DSA_HEAD_DIM),
    ('idx_q', IDX_HEADS * IDX_DIM),
    ('idx_k', IDX_DIM),
    ('idx_w', IDX_HEADS),
    ('mem_q', MEM_HEADS * MEM_HEAD_DIM),
    ('gate', N_BRANCH * D_MODEL),
)
IN_WIDTH = sum(w for _, w in PARTITION)

kernel_name = 'hybrid_gla_dsa_memory_deepnorm'


def _layer_norm(x, g, b):
    xf = x.astype(jnp.float32)
    mu = jnp.mean(xf, axis=-1, keepdims=True)
    var = jnp.mean(jnp.square(xf - mu), axis=-1, keepdims=True)
    return ((xf - mu) * lax.rsqrt(var + LN_EPS) * g + b).astype(x.dtype)


def _split_columns(x, w_in):
    parts = {}
    lo = 0
    for name, width in PARTITION:
        parts[name] = x @ w_in[:, lo:lo + width]
        lo += width
    return parts


def _gla_branch(q, k, v, r, gate_lr, w_gate_up, b_gate, norm_g):
    B, T, _ = q.shape
    H, dk, dv, C = GLA_HEADS, GLA_DK, GLA_DV, GLA_CHUNK
    N = T // C
    f32 = jnp.float32

    def chunks(a, d):
        return a.astype(f32).reshape(B, N, C, H, d).transpose(0, 1, 3, 2, 4)

    log_a = jax.nn.log_sigmoid((gate_lr @ w_gate_up + b_gate).astype(f32)) / GLA_GATE_TEMP
    qc = chunks(q, dk) * (dk ** -0.5)
    kc = chunks(k, dk)
    vc = chunks(v, dv)
    b = jnp.cumsum(chunks(log_a, dk), axis=3)
    b_last = b[:, :, :, -1:, :]
    b_ref = b[:, :, :, C // 2:C // 2 + 1, :]

    causal = jnp.tril(jnp.ones((C, C), dtype=bool))
    scores = jnp.einsum('bnhcd,bnhsd->bnhcs', qc * jnp.exp(b - b_ref), kc * jnp.exp(b_ref - b))
    scores = jnp.where(causal, scores, 0.0)
    o_intra = jnp.einsum('bnhcs,bnhse->bnhce', scores, vc)

    q_inter = qc * jnp.exp(b)
    k_state = kc * jnp.exp(b_last - b)
    decay = jnp.exp(b_last[:, :, :, 0, :])

    def step(S, xs):
        qn, kn, vn, dn = xs
        o = jnp.einsum('bhcd,bhde->bhce', qn, S)
        S = S * dn[..., None] + jnp.einsum('bhcd,bhce->bhde', kn, vn)
        return S, o

    xs = tuple(jnp.moveaxis(a, 1, 0) for a in (q_inter, k_state, vc, decay))
    S0 = jnp.zeros((B, H, dk, dv), f32)
    _, o_inter = lax.scan(step, S0, xs)
    o = o_intra + jnp.moveaxis(o_inter, 0, 1)
    o = o.transpose(0, 1, 3, 2, 4).reshape(B, T, H, dv)
    o = o * lax.rsqrt(jnp.mean(jnp.square(o), axis=-1, keepdims=True) + RMS_EPS)
    o = o.reshape(B, T, H * dv) * norm_g * jax.nn.silu(r.astype(f32))
    return o.astype(r.dtype)


def _dsa_branch(q, k, v, idx_q, idx_k, idx_w):
    B, T, _ = q.shape
    H, d = DSA_HEADS, DSA_HEAD_DIM
    topk = min(DSA_TOPK_MAX, T // 4)
    nblk = T // Q_BLOCK
    f32 = jnp.float32
    q = q.reshape(B, T, H, d)
    k = k.reshape(B, T, H, d)
    v = v.reshape(B, T, H, d)
    iq = idx_q.reshape(B, T, IDX_HEADS, IDX_DIM)
    slopes = 2.0 ** (-8.0 * jnp.arange(1, H + 1, dtype=f32) / H)
    key_pos = jnp.arange(T, dtype=jnp.int32)

    def blocks(a):
        return jnp.moveaxis(a.reshape(B, nblk, Q_BLOCK, *a.shape[2:]), 1, 0)

    gather = jax.vmap(lambda src, ids: src[ids])

    def one_block(args):
        qb, iqb, wb, tq = args
        rel = jax.nn.relu(jnp.einsum('bqgd,bsd->bqgs', iqb, idx_k).astype(f32) * (IDX_DIM ** -0.5))
        score = jnp.einsum('bqg,bqgs->bqs', wb.astype(f32) * (IDX_HEADS ** -0.5), rel)
        causal = key_pos[None, :] <= tq[:, None]
        score = jnp.where(causal[None], score, -jnp.inf)
        _, sel = lax.top_k(score, topk)
        k_sel = gather(k, sel)
        v_sel = gather(v, sel)
        logits = jnp.einsum('bqhd,bqkhd->bqhk', qb, k_sel).astype(f32) * (d ** -0.5)
        dist = (tq[None, :, None] - sel).astype(f32)
        logits = logits - slopes[None, None, :, None] * dist[:, :, None, :]
        valid = sel <= tq[None, :, None]
        logits = jnp.where(valid[:, :, None, :], logits, -jnp.inf)
        p = jax.nn.softmax(logits, axis=-1)
        return jnp.einsum('bqhk,bqkhd->bqhd', p.astype(v.dtype), v_sel)

    xs = (blocks(q), blocks(iq), blocks(idx_w), key_pos.reshape(nblk, Q_BLOCK))
    out = lax.map(one_block, xs)
    return jnp.moveaxis(out, 0, 1).reshape(B, T, H * d)


def _memory_branch(q, mem, w_mem_kv):
    B, T, _ = q.shape
    M = mem.shape[1]
    Hm, dm = MEM_HEADS, MEM_HEAD_DIM
    kv = mem @ w_mem_kv
    km = kv[..., :Hm * dm].reshape(B, M, Hm, dm)
    vm = kv[..., Hm * dm:].reshape(B, M, Hm, dm)
    qm = q.reshape(B, T, Hm, dm)
    logits = jnp.einsum('bthd,bmhd->bhtm', qm, km).astype(jnp.float32) * (dm ** -0.5)
    p = jax.nn.softmax(logits, axis=-1)
    out = jnp.einsum('bhtm,bmhd->bthd', p.astype(vm.dtype), vm)
    return out.reshape(B, T, Hm * dm)


def setup_inputs(seed: int = 0) -> dict:
    key = jax.random.key(seed)
    ks = jax.random.split(key, 22)
    f32 = jnp.float32
    L = DEPTH

    def nrm(k, shape, scale):
        return jax.random.normal(k, shape, f32) * scale

    gla_v = GLA_HEADS * GLA_DV
    dsa_w = DSA_HEADS * DSA_HEAD_DIM
    mem_w = MEM_HEADS * MEM_HEAD_DIM
    return {
        'x': nrm(ks[0], (BATCH, SEQ, D_MODEL), 1.0),
        'mem': nrm(ks[1], (BATCH, MEM_TOKENS, D_MODEL), 1.0),
        'w_in': nrm(ks[2], (L, D_MODEL, IN_WIDTH), D_MODEL ** -0.5),
        'w_gla_gate_up': nrm(ks[3], (L, GLA_GATE_RANK, GLA_HEADS * GLA_DK), GLA_GATE_RANK ** -0.5),
        'b_gla_gate': nrm(ks[4], (L, GLA_HEADS * GLA_DK), 0.01),
        'gla_norm_g': 1.0 + nrm(ks[5], (L, gla_v), 0.01),
        'w_mem_kv': nrm(ks[6], (L, D_MODEL, 2 * mem_w), D_MODEL ** -0.5),
        'w_br_gla': nrm(ks[7], (L, gla_v, D_MODEL), gla_v ** -0.5),
        'w_br_dsa': nrm(ks[8], (L, dsa_w, D_MODEL), dsa_w ** -0.5),
        'w_br_mem': nrm(ks[9], (L, mem_w, D_MODEL), mem_w ** -0.5),
        'b_merge': nrm(ks[10], (L, N_BRANCH * D_MODEL), 0.01),
        'w_o': nrm(ks[11], (L, D_MODEL, D_MODEL), DEEPNORM_BETA * D_MODEL ** -0.5),
        'ln1_g': 1.0 + nrm(ks[12], (L, D_MODEL), 0.01),
        'ln1_b': nrm(ks[13], (L, D_MODEL), 0.01),
        'w_up': nrm(ks[14], (L, D_MODEL, D_FF), D_MODEL ** -0.5),
        'b_up': nrm(ks[15], (L, D_FF), 0.01),
        'w_down': nrm(ks[16], (L, D_FF, D_MODEL), DEEPNORM_BETA * D_FF ** -0.5),
        'b_down': nrm(ks[17], (L, D_MODEL), 0.01),
        'ln2_g': 1.0 + nrm(ks[18], (L, D_MODEL), 0.01),
        'ln2_b': nrm(ks[19], (L, D_MODEL), 0.01),
    }


def reference(x, mem, w_in, w_gla_gate_up, b_gla_gate, gla_norm_g, w_mem_kv, w_br_gla, w_br_dsa,
              w_br_mem, b_merge, w_o, ln1_g, ln1_b, w_up, b_up, w_down, b_down, ln2_g, ln2_b):
    B, T, D = x.shape
    for l in range(DEPTH):
        p = _split_columns(x, w_in[l])
        o_gla = _gla_branch(p['gla_q'], p['gla_k'], p['gla_v'], p['gla_r'], p['gla_gate_lr'],
                            w_gla_gate_up[l], b_gla_gate[l], gla_norm_g[l])
        o_dsa = _dsa_branch(p['dsa_q'], p['dsa_k'], p['dsa_v'], p['idx_q'], p['idx_k'], p['idx_w'])
        o_mem = _memory_branch(p['mem_q'], mem, w_mem_kv[l])
        gates = jax.nn.sigmoid(p['gate'] + b_merge[l]).reshape(B, T, N_BRANCH, D)
        merged = (gates[:, :, 0, :] * (o_gla @ w_br_gla[l])
                  + gates[:, :, 1, :] * (o_dsa @ w_br_dsa[l])
                  + gates[:, :, 2, :] * (o_mem @ w_br_mem[l]))
        y = merged @ w_o[l]
        x = _layer_norm(DEEPNORM_ALPHA * x + y, ln1_g[l], ln1_b[l])
        h = jnp.square(jax.nn.relu(x @ w_up[l] + b_up[l])) @ w_down[l] + b_down[l]
        x = _layer_norm(DEEPNORM_ALPHA * x + h, ln2_g[l], ln2_b[l])
    return x
```

```cpp
#include <hip/hip_runtime.h>
#include <cstdio>
#include <cstdint>

#define LAS __attribute__((address_space(3)))
#define GAS __attribute__((address_space(1)))
typedef unsigned short bf16_t;
typedef short bf16x8 __attribute__((ext_vector_type(8)));
typedef float f32x4 __attribute__((ext_vector_type(4)));
typedef float f32x16 __attribute__((ext_vector_type(16)));
typedef unsigned u32x4 __attribute__((ext_vector_type(4)));
typedef unsigned u32x2 __attribute__((ext_vector_type(2)));

constexpr int BATCH = 2, T = 16384, D = 2048, M = BATCH * T, FF = 8192, NMEM = 256;
constexpr int NCHUNK = T / 64;
constexpr int IN_W = 17504;
constexpr float ALPHA = 1.189207115002721f;
constexpr float LN_EPS = 1e-5f, RMS_EPS = 1e-6f;
constexpr float WG_SCALE = 64.f, WD_SCALE = 256.f, WU_SCALE = 64.f, W1_SCALE = 64.f, WB_SCALE = 64.f, WO_SCALE = 64.f, OMEM_SCALE = 16.f;

constexpr size_t MiB = 1u << 20;
constexpr size_t WS_CTL = 0, CTL_ZERO_BYTES = 1 * MiB;
constexpr int CW_QHEAD = 8192, CW_DNB = 8256, CW_NRM = 8448;
constexpr size_t WS_BRG = 2 * MiB, WS_BRDM = 10 * MiB, WS_WO = 18 * MiB, WS_WUP = 26 * MiB, WS_WDOWN = 58 * MiB, WS_WMKV = 90 * MiB, WS_WG = 98 * MiB, WS_W1 = 122 * MiB;
constexpr size_t WS_MEMB = 167 * MiB, WS_KV = 169 * MiB, WS_DEC = 171 * MiB;
constexpr size_t WS_XB = 176 * MiB;
constexpr size_t WS_GR = 304 * MiB;
constexpr size_t WS_QDM = 432 * MiB;
constexpr size_t WS_DK = 560 * MiB, WS_DV = 624 * MiB, WS_IQ = 688 * MiB;
constexpr size_t WS_SMF = 752 * MiB;
constexpr size_t WS_SMB = 784 * MiB;
constexpr size_t WS_KT = 800 * MiB;
constexpr size_t WS_AM = 864 * MiB;
constexpr size_t WS_SEL = 880 * MiB;
constexpr size_t WS_G = 560 * MiB;
constexpr size_t WS_U = 432 * MiB;
constexpr size_t WS_IKB = 944 * MiB;
constexpr size_t WS_XQ = 948 * MiB;
constexpr size_t WS_END = 1012 * MiB;
constexpr size_t DO_GQ = 0, DO_GK = 64 * MiB, DO_GV = 128 * MiB;
constexpr size_t DO_OGQ = 0, DO_ODMQ = 64 * MiB;

constexpr int LDS_BYTES = 163840;

__device__ __forceinline__ unsigned f2bf(float f) { unsigned u = __builtin_bit_cast(unsigned, f); return (u + 0x7fffu + ((u >> 16) & 1u)) >> 16; }
__device__ __forceinline__ unsigned pk2(float lo, float hi) { return f2bf(lo) | (f2bf(hi) << 16); }
typedef float f32x2_t __attribute__((ext_vector_type(2)));
typedef __bf16 bf16x2_t __attribute__((ext_vector_type(2)));
__device__ __forceinline__ unsigned cvt_pk_bf16(float lo, float hi) { f32x2_t v = {lo, hi}; bf16x2_t b = __builtin_convertvector(v, bf16x2_t); return __builtin_bit_cast(unsigned, b); }
__device__ __forceinline__ unsigned pk_fp8x4(float a, float b, float c, float d) { int w = 0; w = __builtin_amdgcn_cvt_pk_fp8_f32(a, b, w, false); w = __builtin_amdgcn_cvt_pk_fp8_f32(c, d, w, true); return (unsigned)w; }
__device__ __forceinline__ float bf2f(unsigned b) { return __builtin_bit_cast(float, b << 16); }
__device__ __forceinline__ float bflo(unsigned w) { return __builtin_bit_cast(float, w << 16); }
__device__ __forceinline__ float bfhi(unsigned w) { return __builtin_bit_cast(float, w & 0xffff0000u); }
__device__ __forceinline__ float wave_sum(float v) {
#pragma unroll
    for (int o = 1; o < 64; o <<= 1) v += __shfl_xor(v, o);
    return v;
}
__device__ __forceinline__ float wave_max(float v) {
#pragma unroll
    for (int o = 1; o < 64; o <<= 1) v = fmaxf(v, __shfl_xor(v, o));
    return v;
}
#define LDS_WAIT() asm volatile("s_waitcnt lgkmcnt(0)" ::: "memory")
#define WG_BAR_LDS() do { asm volatile("s_waitcnt lgkmcnt(0)" ::: "memory"); __builtin_amdgcn_s_barrier(); asm volatile("" ::: "memory"); } while (0)
#define VM_WAIT() asm volatile("s_waitcnt vmcnt(0)" ::: "memory")

struct Args { const float* in[20]; float* out; unsigned char* ws; int ph_lo, ph_hi; };
enum { I_X = 0, I_MEM, I_WIN, I_WGU, I_BG, I_NG, I_WMKV, I_WBG, I_WBD, I_WBM, I_BMERGE, I_WO, I_LN1G, I_LN1B, I_WUP, I_BUP, I_WDOWN, I_BDOWN, I_LN2G, I_LN2B };

namespace pg8 {
constexpr int BM = 256, BK = 64, HALF = 128, HTB = HALF * BK * 2, STAGE_BYTES = 8 * HTB, NXCD = 8, WGM = 8;
__host__ __device__ __forceinline__ int lds_byte(int r, int c) { const int st = (r >> 4) * 2 + (c >> 5), rr = r & 15, cc = c & 31, ob = rr * 64 + cc * 2; return st * 1024 + (ob ^ (((ob >> 9) & 1) << 5)); }
__host__ __device__ __forceinline__ void stage_rc(int b, int& R, int& C) { const int st = b / 1024, sb = b % 1024, swz = sb ^ (((sb >> 9) & 1) << 5); R = (st >> 1) * 16 + swz / 64; C = (st & 1) * 32 + (swz % 64) / 2; }
__host__ __device__ __forceinline__ int perm32(int rho) { const int n = rho >> 4, i = rho & 15; return 8 * (i >> 2) + 4 * n + (i & 3); }

struct Unit { int pm, pn, sub; };
__device__ __forceinline__ bool tile_of(long L, int nM, int nN, Unit& u) {
    const int nwg = nM * nN; if (L >= nwg) return false;
    int wgid = (int)L; { const int q = nwg / NXCD, r = nwg % NXCD, xcd = wgid % NXCD, off = wgid / NXCD; wgid = (xcd < r ? xcd * (q + 1) : r * (q + 1) + (xcd - r) * q) + off; }
    const int nig = WGM * nN, gid = wgid / nig, fm = gid * WGM, gsz = (nM - fm) < WGM ? (nM - fm) : WGM;
    u.pm = fm + ((wgid % nig) % gsz); u.pn = (wgid % nig) / gsz; u.sub = 0; return true;
}
struct PlainSched {
    const void* A; const void* Bt; int lda, ldb, KT, nM, nN, G, c;
    __device__ __forceinline__ bool next(int i, Unit& u) const { return tile_of((long)i * G + c, nM, nN, u); }
    __device__ __forceinline__ const char* aptr(const Unit& u) const { return (const char*)A + (size_t)u.pm * BM * lda; }
    __device__ __forceinline__ const char* bptr(const Unit& u) const { return (const char*)Bt + (size_t)u.pn * BM * ldb; }
    __device__ __forceinline__ int nt(const Unit&) const { return KT; }
};
struct InProjSched {
    const void* A; const void* Bt; int lda, ldb, KT, nM, nN, G, c; bool lowp;
    __device__ __forceinline__ bool next(int i, Unit& u) const { if (!tile_of((long)i * G + c, nM, nN, u)) return false; u.pn = lowp ? (u.pn < 36 ? u.pn : u.pn + 4) : (u.pn < 4 ? 36 + u.pn : 44); return true; }
    __device__ __forceinline__ const char* aptr(const Unit& u) const { return (const char*)A + (size_t)u.pm * BM * lda; }
    __device__ __forceinline__ const char* bptr(const Unit& u) const { return (const char*)Bt + (size_t)u.pn * BM * ldb; }
    __device__ __forceinline__ int nt(const Unit&) const { return KT; }
};
struct MergeSched {
    const unsigned char* OG; const unsigned char* ODM; const unsigned char* WG; const unsigned char* WDM; int lda, ldb, nM, nN, G, c;
    __device__ __forceinline__ bool next(int i, Unit& u) const { const int ti = i / 3, sub = i - 3 * ti; if (!tile_of((long)ti * G + c, nM, nN, u)) return false; u.sub = sub; return true; }
    __device__ __forceinline__ const char* aptr(const Unit& u) const { const unsigned char* p = u.sub == 0 ? OG : (u.sub == 1 ? ODM : ODM + 1024); return (const char*)(p + (size_t)u.pm * BM * 2048); }
    __device__ __forceinline__ const char* bptr(const Unit& u) const { const unsigned char* p = u.sub == 0 ? WG : (u.sub == 1 ? WDM : WDM + 1024); return (const char*)(p + (size_t)u.pn * BM * 2048); }
    __device__ __forceinline__ int nt(const Unit& u) const { return u.sub == 0 ? 16 : 8; }
};

typedef int v8i __attribute__((ext_vector_type(8)));
typedef int v4i __attribute__((ext_vector_type(4)));
template <bool FP8 = false, class Epi, class Sched>
__device__ __forceinline__ void gemm_phase(LAS unsigned char* lds, const Sched& S, const Epi& E) {
    const int tid = threadIdx.x, wid = __builtin_amdgcn_readfirstlane(tid >> 6), lane = tid & 63, wr = wid >> 2, wc = wid & 3, fr = lane & 15, fq = lane >> 4;
    const int lda = S.lda, ldb = S.ldb;
    unsigned voffA[2], voffB[2];
#pragma unroll
    for (int i = 0; i < 2; ++i) { int R, C; stage_rc(tid * 16 + i * 8192, R, C); const int Rb = (R & ~31) + perm32(R & 31);
        voffA[i] = (unsigned)(R * lda + C * 2); voffB[i] = (unsigned)(Rb * ldb + C * 2); }
    const size_t kstep = (size_t)(BK * 2);
    const size_t hstepA = (size_t)HALF * lda, hstepB = (size_t)HALF * ldb;
    const unsigned ldsw = (unsigned)wid * 1024u;
    const int aoff = lds_byte(wr * 64 + fr, fq * 8), boff = lds_byte(wc * 32 + fr, fq * 8);
#define PG8_SA(b, h) (((b) * 2 + (h)) * HTB)
#define PG8_SB(b, h) ((4 + (b) * 2 + (h)) * HTB)
#define PG8_STAGE(bufoff, gbase, voff) do { _Pragma("unroll") for (int _i = 0; _i < 2; ++_i) \
        __builtin_amdgcn_global_load_lds((const unsigned*)((const char*)(gbase) + (voff)[_i]), (LAS unsigned*)(lds + (bufoff) + ldsw + _i * 8192), 16, 0, 0); } while (0)
#define PG8_CAT(x0, x1) __builtin_shufflevector(x0, x1, 0, 1, 2, 3, 4, 5, 6, 7)
#define PG8_LDA(dst, b, h) do { _Pragma("unroll") for (int m = 0; m < 4; ++m) { if constexpr (FP8) dst##8[m] = PG8_CAT(*(const LAS v4i*)(lds + PG8_SA(b, h) + aoff + m * 2048), *(const LAS v4i*)(lds + PG8_SA(b, h) + aoff + m * 2048 + 1024)); \
        else { _Pragma("unroll") for (int k = 0; k < 2; ++k) dst[m][k] = *(const LAS bf16x8*)(lds + PG8_SA(b, h) + aoff + m * 2048 + k * 1024); } } } while (0)
#define PG8_LDB(dst, b, h) do { _Pragma("unroll") for (int n = 0; n < 2; ++n) { if constexpr (FP8) dst##8[n] = PG8_CAT(*(const LAS v4i*)(lds + PG8_SB(b, h) + boff + n * 2048), *(const LAS v4i*)(lds + PG8_SB(b, h) + boff + n * 2048 + 1024)); \
        else { _Pragma("unroll") for (int k = 0; k < 2; ++k) dst[n][k] = *(const LAS bf16x8*)(lds + PG8_SB(b, h) + boff + n * 2048 + k * 1024); } } } while (0)
#define PG8_MMA(ai, bj, At, Bt) do { __builtin_amdgcn_s_setprio(1); _Pragma("unroll") for (int m = 0; m < 4; ++m) _Pragma("unroll") for (int n = 0; n < 2; ++n) { \
        if constexpr (FP8) asm volatile("v_mfma_f32_16x16x128_f8f6f4 %0, %1, %2, %0" : "+v"(acc[ai][bj][m][n]) : "v"(Bt##8[n]), "v"(At##8[m]));     \
        else { _Pragma("unroll") for (int k = 0; k < 2; ++k) acc[ai][bj][m][n] = __builtin_amdgcn_mfma_f32_16x16x32_bf16(Bt[n][k], At[m][k], acc[ai][bj][m][n], 0, 0, 0); } } \
        __builtin_amdgcn_s_setprio(0); } while (0)
#define PG8_WAIT_V(n) asm volatile("s_waitcnt vmcnt(" #n ")" ::: "memory")
#define PG8_WAIT_L(n) asm volatile("s_waitcnt lgkmcnt(" #n ")" ::: "memory")
#define PG8_BAR __builtin_amdgcn_s_barrier()
#define PG8_SCHED __builtin_amdgcn_sched_barrier(0)
    Unit cur, nxt; int ui = 0;
    if (!S.next(0, cur)) return;
    f32x4 acc[2][2][4][2];
#pragma unroll
    for (int a = 0; a < 2; ++a)
#pragma unroll
        for (int b = 0; b < 2; ++b)
#pragma unroll
            for (int m = 0; m < 4; ++m)
#pragma unroll
                for (int n = 0; n < 2; ++n) acc[a][b][m][n] = (f32x4){0.f, 0.f, 0.f, 0.f};
    bf16x8 At[4][2], B0[2][2], B1[2][2]; v8i At8[4], B08[2], B18[2]; (void)At; (void)B0; (void)B1; (void)At8; (void)B08; (void)B18;
    const char* cA = S.aptr(cur); const char* cB = S.bptr(cur); int nt = S.nt(cur);
    PG8_STAGE(PG8_SB(0, 0), cB, voffB); PG8_STAGE(PG8_SB(0, 1), cB + hstepB, voffB); PG8_STAGE(PG8_SA(0, 0), cA, voffA); PG8_STAGE(PG8_SA(0, 1), cA + hstepA, voffA);
    if (wr == 1) PG8_BAR;
    PG8_WAIT_V(2); PG8_BAR;
    PG8_STAGE(PG8_SB(1, 0), cB + kstep, voffB); PG8_STAGE(PG8_SA(1, 0), cA + kstep, voffA); PG8_STAGE(PG8_SB(1, 1), cB + hstepB + kstep, voffB);
    PG8_WAIT_V(6); PG8_BAR;
    for (;;) {
        const bool has_next = S.next(ui + 1, nxt);
        const char* nA = has_next ? S.aptr(nxt) : cA; const char* nB = has_next ? S.bptr(nxt) : cB;
        for (int t = 0; t < nt; t += 2) {
            const bool last = (t == nt - 2);
            const char* a1 = cA + (size_t)(t + 1) * kstep;
            const char* a2 = last ? nA : cA + (size_t)(t + 2) * kstep; const char* b2 = last ? nB : cB + (size_t)(t + 2) * kstep;
            const char* a3 = a2 + kstep; const char* b3 = b2 + kstep;
            PG8_LDB(B0, 0, 0); PG8_LDB(B1, 0, 1); PG8_SCHED; PG8_LDA(At, 0, 0); PG8_STAGE(PG8_SA(1, 1), a1 + hstepA, voffA);
            PG8_WAIT_V(8); PG8_WAIT_L(0); PG8_BAR; PG8_MMA(0, 0, At, B0); PG8_MMA(0, 1, At, B1); PG8_BAR; PG8_SCHED;
            PG8_LDA(At, 0, 1); PG8_STAGE(PG8_SB(0, 0), b2, voffB); PG8_STAGE(PG8_SB(0, 1), b2 + hstepB, voffB); PG8_STAGE(PG8_SA(0, 0), a2, voffA);
            PG8_WAIT_V(8); PG8_WAIT_L(0); PG8_BAR; PG8_MMA(1, 0, At, B0); PG8_MMA(1, 1, At, B1); PG8_BAR; PG8_SCHED;
            PG8_LDB(B0, 1, 0); PG8_LDB(B1, 1, 1); PG8_SCHED; PG8_LDA(At, 1, 0); PG8_STAGE(PG8_SA(0, 1), a2 + hstepA, voffA);
            PG8_WAIT_V(8); PG8_WAIT_L(0); PG8_BAR; PG8_MMA(0, 0, At, B0); PG8_MMA(0, 1, At, B1); PG8_BAR; PG8_SCHED;
            PG8_LDA(At, 1, 1); PG8_STAGE(PG8_SB(1, 0), b3, voffB); PG8_STAGE(PG8_SB(1, 1), b3 + hstepB, voffB); PG8_STAGE(PG8_SA(1, 0), a3, voffA);
            PG8_WAIT_V(8); PG8_WAIT_L(0); PG8_BAR; PG8_MMA(1, 0, At, B0); PG8_MMA(1, 1, At, B1); PG8_BAR; PG8_SCHED;
        }
        if (wr == 0) PG8_BAR;
        if constexpr (FP8) asm volatile("s_nop 7\n\ts_nop 7\n\ts_nop 7" ::: "memory");
        E(acc, cur, wr, wc, fr, fq);
        if (!has_next) break;
#pragma unroll
        for (int a = 0; a < 2; ++a)
#pragma unroll
            for (int b = 0; b < 2; ++b)
#pragma unroll
                for (int m = 0; m < 4; ++m)
#pragma unroll
                    for (int n = 0; n < 2; ++n) acc[a][b][m][n] = (f32x4){0.f, 0.f, 0.f, 0.f};
        cur = nxt; cA = nA; cB = nB; nt = S.nt(cur); ++ui;
        if (wr == 1) PG8_BAR;
    }
    PG8_WAIT_V(0);
    PG8_BAR;
#undef PG8_SA
#undef PG8_SB
#undef PG8_STAGE
#undef PG8_LDA
#undef PG8_LDB
#undef PG8_MMA
#undef PG8_CAT
#undef PG8_WAIT_V
#undef PG8_WAIT_L
#undef PG8_BAR
#undef PG8_SCHED
}
}
using pg8::Unit;
typedef f32x4 AccT[2][2][4][2];

__device__ __forceinline__ u32x4 pack8(f32x4 v0, f32x4 v1) { u32x4 w; w.x = cvt_pk_bf16(v0[0], v0[1]); w.y = cvt_pk_bf16(v0[2], v0[3]); w.z = cvt_pk_bf16(v1[0], v1[1]); w.w = cvt_pk_bf16(v1[2], v1[3]); return w; }
__device__ __forceinline__ void unpack8(u32x4 w, f32x4& v0, f32x4& v1) { v0 = (f32x4){bflo(w.x), bfhi(w.x), bflo(w.y), bfhi(w.y)}; v1 = (f32x4){bflo(w.z), bfhi(w.z), bflo(w.w), bfhi(w.w)}; }

struct EpiInProj {
    unsigned char* ws; unsigned char* dout; float ascale;
    __device__ __forceinline__ void operator()(const AccT& acc, const Unit& u, int wr, int wc, int fr, int fq) const {
        const int pn = u.pn; bf16_t* base; int ldc, c0;
        if (pn < 4) { base = (bf16_t*)(dout + DO_GQ); ldc = 1024; c0 = pn * 256; }
        else if (pn < 8) { base = (bf16_t*)(dout + DO_GK); ldc = 1024; c0 = (pn - 4) * 256; }
        else if (pn < 16) { base = (bf16_t*)(dout + DO_GV); ldc = 2048; c0 = (pn - 8) * 256; }
        else if (pn < 24) { base = (bf16_t*)(ws + WS_GR); ldc = 2048; c0 = (pn - 16) * 256; }
        else if (pn < 28) { base = (bf16_t*)(ws + WS_QDM); ldc = 2048; c0 = (pn - 24) * 256; }
        else if (pn < 32) { base = (bf16_t*)(ws + WS_DK); ldc = 1024; c0 = (pn - 28) * 256; }
        else if (pn < 36) { base = (bf16_t*)(ws + WS_DV); ldc = 1024; c0 = (pn - 32) * 256; }
        else if (pn < 40) { base = (bf16_t*)(ws + WS_IQ); ldc = 1024; c0 = (pn - 36) * 256; }
        else if (pn < 44) { base = (bf16_t*)(ws + WS_QDM); ldc = 2048; c0 = 1024 + (pn - 40) * 256; }
        else { base = (bf16_t*)(ws + WS_SMB); ldc = 256; c0 = 0; }
        float* fbase = (float*)(ws + WS_SMF);
#pragma unroll
        for (int ai = 0; ai < 2; ++ai)
#pragma unroll
            for (int m = 0; m < 4; ++m) { const size_t row = (size_t)u.pm * 256 + ai * 128 + wr * 64 + m * 16 + fr;
#pragma unroll
                for (int bj = 0; bj < 2; ++bj) { const int cl = bj * 128 + wc * 32 + 8 * fq;
                    *(u32x4*)(base + row * ldc + c0 + cl) = pack8(acc[ai][bj][m][0] * ascale, acc[ai][bj][m][1] * ascale);
                    if (pn == 44) { *(f32x4*)(fbase + row * 256 + cl) = acc[ai][bj][m][0]; *(f32x4*)(fbase + row * 256 + cl + 4) = acc[ai][bj][m][1];
                        if (cl < 64) *(u32x4*)((bf16_t*)(ws + WS_IKB) + ((((row >> 5) * 4 + (cl >> 4)) * 64 + ((cl >> 3) & 1) * 32 + (row & 31)) << 3)) = pack8(acc[ai][bj][m][0], acc[ai][bj][m][1]); } } }
    }
};
struct EpiKV {
    bf16_t* KM; bf16_t* VMT;
    __device__ __forceinline__ void operator()(const AccT& acc, const Unit& u, int wr, int wc, int fr, int fq) const {
#pragma unroll
        for (int ai = 0; ai < 2; ++ai)
#pragma unroll
            for (int m = 0; m < 4; ++m) { const int row = u.pm * 256 + ai * 128 + wr * 64 + m * 16 + fr;
#pragma unroll
                for (int bj = 0; bj < 2; ++bj) { const int col = u.pn * 256 + bj * 128 + wc * 32 + 8 * fq;
                    if (u.pn < 4) *(u32x4*)(KM + (size_t)row * 1024 + col) = pack8(acc[ai][bj][m][0], acc[ai][bj][m][1]);
                    else { bf16_t* vp = VMT + ((size_t)(row >> 8) * 1024 + (col - 1024)) * 256 + (row & 255);
#pragma unroll
                        for (int j = 0; j < 4; ++j) { vp[(size_t)j * 256] = (bf16_t)f2bf(acc[ai][bj][m][0][j]); vp[(size_t)(j + 4) * 256] = (bf16_t)f2bf(acc[ai][bj][m][1][j]); } } } }
    }
};
struct EpiGate {
    bf16_t* O; const float* bias;
    __device__ __forceinline__ void operator()(const AccT& acc, const Unit& u, int wr, int wc, int fr, int fq) const {
#pragma unroll
        for (int bj = 0; bj < 2; ++bj) { const int col = u.pn * 256 + bj * 128 + wc * 32 + 8 * fq;
            const f32x4 b0 = *(const f32x4*)(bias + col), b1 = *(const f32x4*)(bias + col + 4);
#pragma unroll
            for (int ai = 0; ai < 2; ++ai)
#pragma unroll
                for (int m = 0; m < 4; ++m) { const size_t row = (size_t)u.pm * 256 + ai * 128 + wr * 64 + m * 16 + fr;
                    f32x4 v0 = acc[ai][bj][m][0] * (1.0f / WG_SCALE) + b0, v1 = acc[ai][bj][m][1] * (1.0f / WG_SCALE) + b1;
#pragma unroll
                    for (int j = 0; j < 4; ++j) { v0[j] = 1.f / (1.f + __expf(-v0[j])); v1[j] = 1.f / (1.f + __expf(-v1[j])); }
                    *(u32x4*)(O + row * 6144 + col) = pack8(v0, v1); } }
    }
};
struct EpiMerge {
    bf16_t* MG; const bf16_t* G; unsigned char* MQ;
    __device__ __forceinline__ void operator()(const AccT& acc, const Unit& u, int wr, int wc, int fr, int fq) const {
        const float sc = u.sub == 2 ? 1.0f / (WB_SCALE * OMEM_SCALE) : 1.0f / WB_SCALE;
#pragma unroll
        for (int ai = 0; ai < 2; ++ai)
#pragma unroll
            for (int m = 0; m < 4; ++m) { const size_t row = (size_t)u.pm * 256 + ai * 128 + wr * 64 + m * 16 + fr;
#pragma unroll
                for (int bj = 0; bj < 2; ++bj) { const int col = u.pn * 256 + bj * 128 + wc * 32 + 8 * fq;
                    f32x4 g0, g1; unpack8(*(const u32x4*)(G + row * 6144 + u.sub * 2048 + col), g0, g1);
                    f32x4 v0 = acc[ai][bj][m][0] * sc * g0, v1 = acc[ai][bj][m][1] * sc * g1;
                    if (u.sub != 0) { f32x4 o0, o1; unpack8(*(const u32x4*)(MG + row * 2048 + col), o0, o1); v0 += o0; v1 += o1; }
                    if (u.sub != 2) *(u32x4*)(MG + row * 2048 + col) = pack8(v0, v1);
                    else *(u32x2*)(MQ + row * 2048 + col) = (u32x2){pk_fp8x4(v0[0], v0[1], v0[2], v0[3]), pk_fp8x4(v1[0], v1[1], v1[2], v1[3])}; } }
        asm volatile("" ::: "memory");
    }
};
struct EpiResid {
    const float* base; float* out; const float* bias; float ascale;
    __device__ __forceinline__ void operator()(const AccT& acc, const Unit& u, int wr, int wc, int fr, int fq) const {
#pragma unroll
        for (int bj = 0; bj < 2; ++bj) { const int col = u.pn * 256 + bj * 128 + wc * 32 + 8 * fq;
            f32x4 b0 = (f32x4){0.f, 0.f, 0.f, 0.f}, b1 = b0; if (bias) { b0 = *(const f32x4*)(bias + col); b1 = *(const f32x4*)(bias + col + 4); }
#pragma unroll
            for (int ai = 0; ai < 2; ++ai)
#pragma unroll
                for (int m = 0; m < 4; ++m) { const size_t off = ((size_t)u.pm * 256 + ai * 128 + wr * 64 + m * 16 + fr) * 2048 + col;
                    const f32x4 x0 = *(const f32x4*)(base + off), x1 = *(const f32x4*)(base + off + 4);
                    *(f32x4*)(out + off) = x0 * ALPHA + acc[ai][bj][m][0] * ascale + b0; *(f32x4*)(out + off + 4) = x1 * ALPHA + acc[ai][bj][m][1] * ascale + b1; } }
    }
};
struct EpiRelu2 {
    unsigned char* O; const float* bias;
    __device__ __forceinline__ void operator()(const AccT& acc, const Unit& u, int wr, int wc, int fr, int fq) const {
#pragma unroll
        for (int bj = 0; bj < 2; ++bj) { const int col = u.pn * 256 + bj * 128 + wc * 32 + 8 * fq;
            const f32x4 b0 = *(const f32x4*)(bias + col), b1 = *(const f32x4*)(bias + col + 4);
#pragma unroll
            for (int ai = 0; ai < 2; ++ai)
#pragma unroll
                for (int m = 0; m < 4; ++m) { const size_t row = (size_t)u.pm * 256 + ai * 128 + wr * 64 + m * 16 + fr;
                    f32x4 v0 = acc[ai][bj][m][0] * (1.0f / WU_SCALE) + b0, v1 = acc[ai][bj][m][1] * (1.0f / WU_SCALE) + b1;
#pragma unroll
                    for (int j = 0; j < 4; ++j) { const float a = fmaxf(v0[j], 0.f), b = fmaxf(v1[j], 0.f); v0[j] = a * a; v1[j] = b * b; }
                    *(u32x2*)(O + row * 8192 + col) = (u32x2){pk_fp8x4(v0[0], v0[1], v0[2], v0[3]), pk_fp8x4(v1[0], v1[1], v1[2], v1[3])}; } }
    }
};

#define XB_TMO      128
#define XB_XCNT(j)  (256  + 64 * (j))
#define XB_XSUB(j)  (1280 + 64 * (j))
#define XB_XGEN(j)  (2304 + 64 * (j))
#define XB_TOP      3328
#define XB_TOPGEN   3392
#define XCD_BAR_WORDS 3456
#define XB_SPIN_CAP (1u << 18)
__device__ __forceinline__ unsigned xb_ld(unsigned* p)              { return __hip_atomic_load(p, __ATOMIC_RELAXED, __HIP_MEMORY_SCOPE_AGENT); }
__device__ __forceinline__ unsigned xb_add(unsigned* p, unsigned v) { return __hip_atomic_fetch_add(p, v, __ATOMIC_RELAXED, __HIP_MEMORY_SCOPE_AGENT); }
__device__ __forceinline__ unsigned xb_xcc_id() { return (unsigned)__builtin_amdgcn_s_getreg((3 << 11) | 20) & 0xFu; }
#define XB_SPIN(cond, bar) do { unsigned _sp = 0; while (cond) { __builtin_amdgcn_s_sleep(1); \
    if ((++_sp & 255u) == 0u) { if (xb_ld(&(bar)[XB_TMO])) break; if (_sp > XB_SPIN_CAP) { atomicAdd(&(bar)[XB_TMO], 1u); break; } } } } while (0)
struct XcdBarrier { unsigned* bar; unsigned x; volatile LAS unsigned* st; };
__device__ __forceinline__ XcdBarrier xcd_barrier_post(unsigned* bar, volatile LAS unsigned* st) {
    XcdBarrier b; b.bar = bar; b.x = xb_xcc_id(); b.st = st;
    if (threadIdx.x == 0) (void)xb_add(&bar[XB_XCNT(b.x)], 1u);
    return b;
}
__device__ __forceinline__ void xcd_barrier_complete(unsigned* bar, unsigned x, unsigned& nloc, unsigned& nx) {
    const unsigned G = gridDim.x * gridDim.y * gridDim.z;
    unsigned sum, cnt, mine, sp = 0u;
    for (;;) {
        sum = 0u; cnt = 0u; mine = 0u;
#pragma unroll
        for (unsigned j = 0; j < 16; ++j) { const unsigned c = xb_ld(&bar[XB_XCNT(j)]); sum += c; cnt += (c > 0u) ? 1u : 0u; mine = (j == x) ? c : mine; }
        if (sum == G) break;
        __builtin_amdgcn_s_sleep(1);
        if ((++sp & 255u) == 0u) { if (xb_ld(&bar[XB_TMO])) break; if (sp > XB_SPIN_CAP) { atomicAdd(&bar[XB_TMO], 1u); break; } }
    }
    nloc = mine > 0u ? mine : 1u; nx = cnt > 0u ? cnt : 1u;
}
__device__ __forceinline__ void xcd_barrier(const XcdBarrier& b) {
    asm volatile("s_waitcnt vmcnt(0)" ::: "memory");
    __syncthreads();
    if (threadIdx.x == 0) {
        unsigned* bar = b.bar;
        __builtin_amdgcn_s_waitcnt(0);
        unsigned nloc = b.st[0], nx = b.st[1];
        if (nloc == 0u) { xcd_barrier_complete(bar, b.x, nloc, nx); b.st[0] = nloc; b.st[1] = nx; }
        const unsigned old = xb_add(&bar[XB_XSUB(b.x)], 1u);
        const unsigned gen = old / nloc;
        if (old + 1u == (gen + 1u) * nloc) {
            __builtin_amdgcn_fence(__ATOMIC_RELEASE, "agent");
            asm volatile("s_waitcnt vmcnt(0)" ::: "memory");
            const unsigned og = xb_add(&bar[XB_TOP], 1u);
            const unsigned tg = og / nx;
            if (og + 1u == (tg + 1u) * nx) xb_add(&bar[XB_TOPGEN], 1u);
            else XB_SPIN(xb_ld(&bar[XB_TOPGEN]) == tg, bar);
            __builtin_amdgcn_fence(__ATOMIC_ACQUIRE, "agent");
            xb_add(&bar[XB_XGEN(b.x)], 1u);
            asm volatile("s_waitcnt vmcnt(0)" ::: "memory");
        } else {
            XB_SPIN(xb_ld(&bar[XB_XGEN(b.x)]) == gen, bar);
            __builtin_amdgcn_fence(__ATOMIC_ACQUIRE, "agent");
            asm volatile("s_waitcnt vmcnt(0)" ::: "memory");
        }
    }
    __syncthreads();
}

__device__ __forceinline__ bf16_t* w1_row(unsigned char* ws, int c) {
    int r; bf16_t* base = (bf16_t*)(ws + WS_W1);
    if (c < 6144) r = c;
    else if (c < 6160) r = 44 * 256 + 80 + (c - 6144);
    else if (c < 10256) r = 6144 + (c - 6160);
    else if (c < 10320) r = 44 * 256 + (c - 10256);
    else if (c < 10336) r = 44 * 256 + 64 + (c - 10320);
    else if (c < 11360) r = 10240 + (c - 10336);
    else return nullptr;
    return base + (size_t)r * 2048;
}
struct RowLin { bf16_t* d; size_t pitch; __device__ __forceinline__ bf16_t* operator()(int n) const { return d + (size_t)n * pitch; } };
struct RowLin8 { unsigned char* d; size_t pitch; __device__ __forceinline__ unsigned char* operator()(int n) const { return d + (size_t)n * pitch; } };
template <class RowFn>
__device__ __forceinline__ void transpose_item8(const float* W, int N, LAS float* scr, int item, int lane, RowFn rowp, float scale) {
    const int nblk = N / 32, kb = item / nblk, nb = item % nblk, k0 = 64 * kb, n0 = 32 * nb;
#pragma unroll 8
    for (int i = 0; i < 32; ++i) { const int kk = 2 * i + (lane >> 5); scr[kk * 33 + (lane & 31)] = W[(size_t)(k0 + kk) * N + n0 + (lane & 31)]; }
    LDS_WAIT(); asm volatile("" ::: "memory");
    const int c = lane & 7;
#pragma unroll
    for (int j = 0; j < 4; ++j) { const int n = (lane >> 3) + 8 * j; const LAS float* sp = scr + (8 * c) * 33 + n;
        *(u32x2*)(rowp(n0 + n) + k0 + 8 * c) = (u32x2){pk_fp8x4(sp[0 * 33] * scale, sp[1 * 33] * scale, sp[2 * 33] * scale, sp[3 * 33] * scale), pk_fp8x4(sp[4 * 33] * scale, sp[5 * 33] * scale, sp[6 * 33] * scale, sp[7 * 33] * scale)}; }
    LDS_WAIT(); asm volatile("" ::: "memory");
}
__device__ __forceinline__ bool w1_is_bf16(int c) { return (c >= 6144 && c < 6160) || (c >= 9232 && c < 10336); }
__device__ __forceinline__ void transpose_item_w1(const float* W, LAS float* scr, int item, int lane, unsigned char* ws) {
    constexpr int N = IN_W; const int nblk = N / 32, kb = item / nblk, nb = item % nblk, k0 = 64 * kb, n0 = 32 * nb;
#pragma unroll 8
    for (int i = 0; i < 32; ++i) { const int kk = 2 * i + (lane >> 5); scr[kk * 33 + (lane & 31)] = W[(size_t)(k0 + kk) * N + n0 + (lane & 31)]; }
    LDS_WAIT(); asm volatile("" ::: "memory");
    const int c = lane & 7;
#pragma unroll
    for (int j = 0; j < 4; ++j) { const int n = (lane >> 3) + 8 * j; const LAS float* sp = scr + (8 * c) * 33 + n; bf16_t* rp = w1_row(ws, n0 + n);
        if (w1_is_bf16(n0 + n)) { u32x4 o; o.x = pk2(sp[0 * 33], sp[1 * 33]); o.y = pk2(sp[2 * 33], sp[3 * 33]); o.z = pk2(sp[4 * 33], sp[5 * 33]); o.w = pk2(sp[6 * 33], sp[7 * 33]); *(u32x4*)(rp + k0 + 8 * c) = o; }
        else *(u32x2*)((unsigned char*)rp + k0 + 8 * c) = (u32x2){pk_fp8x4(sp[0 * 33] * W1_SCALE, sp[1 * 33] * W1_SCALE, sp[2 * 33] * W1_SCALE, sp[3 * 33] * W1_SCALE), pk_fp8x4(sp[4 * 33] * W1_SCALE, sp[5 * 33] * W1_SCALE, sp[6 * 33] * W1_SCALE, sp[7 * 33] * W1_SCALE)}; }
    LDS_WAIT(); asm volatile("" ::: "memory");
}
template <class RowFn>
__device__ __forceinline__ void transpose_item(const float* W, int N, LAS float* scr, int item, int lane, RowFn rowp) {
    const int nblk = N / 32, kb = item / nblk, nb = item % nblk, k0 = 64 * kb, n0 = 32 * nb;
#pragma unroll 8
    for (int i = 0; i < 32; ++i) { const int kk = 2 * i + (lane >> 5); scr[kk * 33 + (lane & 31)] = W[(size_t)(k0 + kk) * N + n0 + (lane & 31)]; }
    LDS_WAIT(); asm volatile("" ::: "memory");
    const int c = lane & 7;
#pragma unroll
    for (int j = 0; j < 4; ++j) { const int n = (lane >> 3) + 8 * j; const LAS float* s = scr + (8 * c) * 33 + n;
        u32x4 o; o.x = pk2(s[0 * 33], s[1 * 33]); o.y = pk2(s[2 * 33], s[3 * 33]); o.z = pk2(s[4 * 33], s[5 * 33]); o.w = pk2(s[6 * 33], s[7 * 33]);
        *(u32x4*)(rowp(n0 + n) + k0 + 8 * c) = o; }
    LDS_WAIT(); asm volatile("" ::: "memory");
}
__device__ __forceinline__ void cvt_rows(const float* src, bf16_t* dst, size_t n8, size_t i0, size_t stride) {
    for (size_t i = i0; i < n8; i += stride) { const f32x4 a = ((const f32x4*)src)[2 * i], b = ((const f32x4*)src)[2 * i + 1];
        u32x4 o; o.x = pk2(a[0], a[1]); o.y = pk2(a[2], a[3]); o.z = pk2(b[0], b[1]); o.w = pk2(b[2], b[3]); ((u32x4*)dst)[i] = o; }
}
__device__ __forceinline__ void ph_prologue(const Args& a, LAS unsigned char* lds, int bid, int nblk) {
    unsigned char* ws = a.ws; const int tid = threadIdx.x, lane = tid & 63, wave = __builtin_amdgcn_readfirstlane(tid >> 6);
    const size_t g0 = (size_t)bid * 512 + tid, gs = (size_t)nblk * 512;
    { const float* src = a.in[I_X]; bf16_t* dst = (bf16_t*)(ws + WS_XB); unsigned char* dq = ws + WS_XQ;
      for (size_t i = g0; i < (size_t)M * D / 8; i += gs) { const f32x4 p = ((const f32x4*)src)[2 * i], q = ((const f32x4*)src)[2 * i + 1];
          u32x4 o; o.x = pk2(p[0], p[1]); o.y = pk2(p[2], p[3]); o.z = pk2(q[0], q[1]); o.w = pk2(q[2], q[3]); ((u32x4*)dst)[i] = o;
          ((u32x2*)dq)[i] = (u32x2){pk_fp8x4(p[0], p[1], p[2], p[3]), pk_fp8x4(q[0], q[1], q[2], q[3])}; } }
    cvt_rows(a.in[I_MEM], (bf16_t*)(ws + WS_MEMB), (size_t)BATCH * NMEM * D / 8, g0, gs);
    { u32x4* z = (u32x4*)((bf16_t*)(ws + WS_W1) + (size_t)(44 * 256 + 96) * 2048); const u32x4 zero = {0u, 0u, 0u, 0u};
      for (size_t i = g0; i < (size_t)160 * 2048 / 8; i += gs) z[i] = zero; }
    LAS float* scr = (LAS float*)(lds + wave * 8448);
    const int gw = bid * 8 + wave, NGW = nblk * 8;
    constexpr int I_1 = 32 * (IN_W / 32), I_BG = 32 * 64, I_BD = 16 * 64, I_BM = 16 * 64, I_O = 32 * 64, I_UP = 32 * 256, I_DN = 128 * 64, I_KV = 32 * 64;
    constexpr int NITEMS = I_1 + I_BG + I_BD + I_BM + I_O + I_UP + I_DN + I_KV;
    for (int it = gw; it < NITEMS; it += NGW) {
        int r = it;
        if (r < I_1) { if ((r % (IN_W / 32)) * 32 >= 11360) transpose_item8(a.in[I_WIN], IN_W, scr, r, lane, RowLin8{ws + WS_WG - (size_t)11360 * 2048, 2048}, WG_SCALE);
                       else transpose_item_w1(a.in[I_WIN], scr, r, lane, ws); continue; } r -= I_1;
        if (r < I_BG) { transpose_item8(a.in[I_WBG], 2048, scr, r, lane, RowLin8{ws + WS_BRG, 2048}, WB_SCALE); continue; } r -= I_BG;
        if (r < I_BD) { transpose_item8(a.in[I_WBD], 2048, scr, r, lane, RowLin8{ws + WS_BRDM, 2048}, WB_SCALE); continue; } r -= I_BD;
        if (r < I_BM) { transpose_item8(a.in[I_WBM], 2048, scr, r, lane, RowLin8{ws + WS_BRDM + 1024, 2048}, WB_SCALE); continue; } r -= I_BM;
        if (r < I_O) { transpose_item8(a.in[I_WO], 2048, scr, r, lane, RowLin8{ws + WS_WO, 2048}, WO_SCALE); continue; } r -= I_O;
        if (r < I_UP) { transpose_item8(a.in[I_WUP], 8192, scr, r, lane, RowLin8{ws + WS_WUP, 2048}, WU_SCALE); continue; } r -= I_UP;
        if (r < I_DN) { transpose_item8(a.in[I_WDOWN], 2048, scr, r, lane, RowLin8{ws + WS_WDOWN, 8192}, WD_SCALE); continue; } r -= I_DN;
        { transpose_item(a.in[I_WMKV], 2048, scr, r, lane, RowLin{(bf16_t*)(ws + WS_WMKV), 2048}); }
    }
}

__device__ __forceinline__ void ph_gla_prep(const Args& a, LAS unsigned char* lds, int bid, int nblk) {
    unsigned char* ws = a.ws; const int tid = threadIdx.x, lane = tid & 63, wave = __builtin_amdgcn_readfirstlane(tid >> 6);
    LAS float* bcum = (LAS float*)lds;
    LAS bf16_t* qs = (LAS bf16_t*)(lds + 65536);
    LAS bf16_t* ks = (LAS bf16_t*)(lds + 65536 + 33792);
    LAS float* glr = (LAS float*)(lds + 65536 + 2 * 33792);
    bf16_t* GQ = (bf16_t*)((unsigned char*)a.out + DO_GQ); const bf16_t* GK = (const bf16_t*)((unsigned char*)a.out + DO_GK);
    const float* SMF = (const float*)(ws + WS_SMF); bf16_t* KT = (bf16_t*)(ws + WS_KT); bf16_t* AM = (bf16_t*)(ws + WS_AM); float* DEC = (float*)(ws + WS_DEC);
    const float* wgu = a.in[I_WGU]; const float* bgv = a.in[I_BG];
    for (int item = bid; item < BATCH * NCHUNK * 4; item += nblk) {
        const int h = item & 3, bn = item >> 2, b = bn / NCHUNK, n = bn % NCHUNK; const size_t t0 = (size_t)b * T + (size_t)n * 64;
        for (int i = tid; i < 1024; i += 512) glr[i] = SMF[(t0 + (i >> 4)) * 256 + 80 + (i & 15)];
        __syncthreads();
        const int d = tid & 255, half = tid >> 8, col = h * 256 + d;
        float wu[16];
#pragma unroll
        for (int r = 0; r < 16; ++r) wu[r] = wgu[r * 1024 + col];
        const float bg = bgv[col];
        float run = 0.f;
        for (int cc = 0; cc < 32; ++cc) { const int c = half * 32 + cc; float z = bg;
#pragma unroll
            for (int r = 0; r < 16; ++r) z += glr[c * 16 + r] * wu[r];
            const float ls = fminf(z, 0.f) - __logf(1.f + __expf(-fabsf(z)));
            run += ls * (1.0f / 16.0f); bcum[c * 256 + d] = run; }
        __syncthreads();
        const float first = bcum[31 * 256 + d], b_ref = first + bcum[32 * 256 + d], b_last = first + bcum[63 * 256 + d];
        unsigned kst[16];
#pragma unroll
        for (int c8 = 0; c8 < 4; ++c8) {
            unsigned short qraw[8], kraw[8];
#pragma unroll
            for (int e = 0; e < 8; ++e) { const size_t gi = (t0 + half * 32 + c8 * 8 + e) * 1024 + col; qraw[e] = GQ[gi]; kraw[e] = GK[gi]; }
#pragma unroll
            for (int e = 0; e < 8; ++e) { const int cc = c8 * 8 + e, c = half * 32 + cc; const float bt = bcum[c * 256 + d] + (half ? first : 0.f);
                const size_t gi = (t0 + c) * 1024 + col;
                const float q = bf2f(qraw[e]) * 0.0625f, k = bf2f(kraw[e]);
                qs[c * 264 + d] = (bf16_t)f2bf(q * __expf(bt - b_ref)); ks[c * 264 + d] = (bf16_t)f2bf(k * __expf(b_ref - bt));
                GQ[gi] = (bf16_t)f2bf(q * __expf(bt));
                const unsigned kv = f2bf(k * __expf(b_last - bt));
                if (cc & 1) kst[cc >> 1] |= kv << 16; else kst[cc >> 1] = kv; } }
        { u32x4* kp = (u32x4*)(KT + (size_t)item * 16384 + d * 64 + half * 32);
#pragma unroll
          for (int j = 0; j < 4; ++j) kp[j] = (u32x4){kst[4 * j], kst[4 * j + 1], kst[4 * j + 2], kst[4 * j + 3]}; }
        if (half == 0) DEC[(size_t)item * 256 + d] = __expf(b_last);
        __syncthreads();
        { const int mt = wave >> 1, fr = lane & 15, fq = lane >> 4;
#pragma unroll
          for (int nn = 0; nn < 2; ++nn) { const int ntl = (wave & 1) * 2 + nn; f32x4 acc = {0.f, 0.f, 0.f, 0.f};
#pragma unroll
              for (int k8 = 0; k8 < 8; ++k8) { const bf16x8 av = *(const LAS bf16x8*)(qs + (mt * 16 + fr) * 264 + k8 * 32 + fq * 8), bv = *(const LAS bf16x8*)(ks + (ntl * 16 + fr) * 264 + k8 * 32 + fq * 8);
                  acc = __builtin_amdgcn_mfma_f32_16x16x32_bf16(av, bv, acc, 0, 0, 0); }
#pragma unroll
              for (int i = 0; i < 4; ++i) { const int tok = mt * 16 + fq * 4 + i, s = ntl * 16 + fr; AM[(size_t)item * 4096 + tok * 64 + s] = (bf16_t)f2bf(s <= tok ? acc[i] : 0.f); } } }
        __syncthreads();
    }
}
struct ScanOps { u32x2 q[4][2]; bf16x8 k[2][2]; f32x4 dec[2]; bf16x8 af; u32x4 v; };
struct ScanOff { unsigned q, k, dec, af, v; };
__device__ __forceinline__ void scan_load(ScanOps& X, const ScanOff& O, const bf16_t* GQ, const bf16_t* GV, const bf16_t* KT, const bf16_t* AM, const float* DEC, int b, int h, int sl, int n, int w, int tid) {
    const size_t item = ((size_t)b * NCHUNK + n) * 4 + h, t0 = (size_t)b * T + (size_t)n * 64;
    const char* qb = (const char*)(GQ + t0 * 1024 + h * 256 + 32 * w); const char* kb = (const char*)(KT + item * 16384 + (size_t)(32 * w) * 64);
    const char* db = (const char*)(DEC + item * 256 + 32 * w); const char* ab = (const char*)(AM + item * 4096 + (size_t)((w >> 1) * 16) * 64 + 32 * (w & 1)); const char* vb = (const char*)(GV + t0 * 2048 + h * 512 + sl * 32);
#pragma unroll
    for (int mt = 0; mt < 4; ++mt) { X.q[mt][0] = *(const u32x2*)(qb + O.q + mt * 16 * 2048); X.q[mt][1] = *(const u32x2*)(qb + O.q + mt * 16 * 2048 + 32); }
#pragma unroll
    for (int i = 0; i < 2; ++i) { X.k[i][0] = *(const bf16x8*)(kb + O.k + i * 16 * 128); X.k[i][1] = *(const bf16x8*)(kb + O.k + i * 16 * 128 + 64); X.dec[i] = *(const f32x4*)(db + O.dec + i * 64); }
    X.af = *(const bf16x8*)(ab + O.af);
    if (tid < 256) X.v = *(const u32x4*)(vb + O.v);
}
__device__ __forceinline__ void scan_put_v(const ScanOps& X, LAS unsigned char* vt, int tid) {
    if (tid < 256) { const int tok = tid >> 2, c0 = 8 * (tid & 3); const unsigned w[4] = {X.v.x, X.v.y, X.v.z, X.v.w};
#pragma unroll
        for (int c = 0; c < 8; ++c) *(LAS unsigned short*)(vt + (c0 + c) * 144 + tok * 2) = (unsigned short)((c & 1) ? (w[c >> 1] >> 16) : (w[c >> 1] & 0xffffu)); }
}
__device__ __forceinline__ void ph_gla_scan(const Args& a, LAS unsigned char* lds, int bid, int nblk) {
    unsigned char* ws = a.ws; const int tid = threadIdx.x, lane = tid & 63, w = __builtin_amdgcn_readfirstlane(tid >> 6), fr = lane & 15, fq = lane >> 4;
    LAS unsigned char* vtb = lds;
    LAS float* red = (LAS float*)(lds + 9216);
    constexpr int RED_W = 8 * 256, RED_B = 8 * RED_W;
    const bf16_t* GQ = (const bf16_t*)((unsigned char*)a.out + DO_GQ); bf16_t* GV = (bf16_t*)((unsigned char*)a.out + DO_GV);
    const bf16_t* KT = (const bf16_t*)(ws + WS_KT); const bf16_t* AM = (const bf16_t*)(ws + WS_AM); const float* DEC = (const float*)(ws + WS_DEC);
    for (int task = bid; task < 128; task += nblk) {
        const int b = task >> 6, h = (task >> 4) & 3, sl = task & 15;
        f32x4 S[2][2];
#pragma unroll
        for (int i = 0; i < 2; ++i)
#pragma unroll
            for (int j = 0; j < 2; ++j) S[i][j] = (f32x4){0.f, 0.f, 0.f, 0.f};
        ScanOps oa, ob, oc;
        const ScanOff SO{(unsigned)(fr * 2048 + 8 * fq), (unsigned)(fr * 128 + 16 * fq), (unsigned)(16 * fq), (unsigned)(fr * 128 + 16 * fq), (unsigned)((tid >> 2) * 4096 + 16 * (tid & 3))};
        scan_load(oa, SO, GQ, GV, KT, AM, DEC, b, h, sl, 0, w, tid);
        scan_load(ob, SO, GQ, GV, KT, AM, DEC, b, h, sl, 1, w, tid);
        scan_put_v(oa, vtb, tid);
        WG_BAR_LDS();
#define SCAN_STEP(CUR, NXT, FAR, n) do {                                                                                                             \
            { const int nf = (n) + 2 < NCHUNK ? (n) + 2 : NCHUNK - 1; scan_load(FAR, SO, GQ, GV, KT, AM, DEC, b, h, sl, nf, w, tid); }               \
            LAS unsigned char* vt = vtb + ((n) & 1) * 4608; LAS float* rb = red + ((n) & 1) * RED_B;                                                 \
            _Pragma("unroll") for (int j = 0; j < 2; ++j) {                                                                                          \
                const bf16x8 vf0 = *(const LAS bf16x8*)(vt + (16 * j + fr) * 144 + (8 * fq) * 2), vf1 = *(const LAS bf16x8*)(vt + (16 * j + fr) * 144 + (32 + 8 * fq) * 2); \
                const u32x4 sw = {cvt_pk_bf16(S[0][j][0], S[0][j][1]), cvt_pk_bf16(S[0][j][2], S[0][j][3]), cvt_pk_bf16(S[1][j][0], S[1][j][1]), cvt_pk_bf16(S[1][j][2], S[1][j][3])}; \
                const bf16x8 Sb = __builtin_bit_cast(bf16x8, sw);                                                                                    \
                const f32x4 z = {0.f, 0.f, 0.f, 0.f}; const f32x4 ia = __builtin_amdgcn_mfma_f32_16x16x32_bf16(CUR.af, (w & 1) ? vf1 : vf0, z, 0, 0, 0); \
                _Pragma("unroll") for (int mt = 0; mt < 4; ++mt) { const u32x4 qw = {CUR.q[mt][0].x, CUR.q[mt][0].y, CUR.q[mt][1].x, CUR.q[mt][1].y}; \
                    f32x4 op = __builtin_amdgcn_mfma_f32_16x16x32_bf16(__builtin_bit_cast(bf16x8, qw), Sb, z, 0, 0, 0); if (mt == (w >> 1)) op += ia; \
                    *(LAS f32x4*)(rb + w * RED_W + (j * 4 + mt) * 256 + lane * 4) = op; }                                                          \
                _Pragma("unroll") for (int i = 0; i < 2; ++i) { S[i][j] = __builtin_amdgcn_mfma_f32_16x16x32_bf16(CUR.k[i][0], vf0, S[i][j] * CUR.dec[i], 0, 0, 0); \
                    S[i][j] = __builtin_amdgcn_mfma_f32_16x16x32_bf16(CUR.k[i][1], vf1, S[i][j], 0, 0, 0); } }                                     \
            scan_put_v(NXT, vtb + (((n) + 1) & 1) * 4608, tid);                                                                                      \
            WG_BAR_LDS();                                                                                                                            \
            { f32x4 acc = *(const LAS f32x4*)(rb + w * 256 + lane * 4);           \
              _Pragma("unroll") for (int ww = 1; ww < 8; ++ww) acc += *(const LAS f32x4*)(rb + ww * RED_W + w * 256 + lane * 4);                   \
              bf16_t* op_ = GV + ((size_t)b * T + (size_t)(n) * 64 + (w & 3) * 16 + 4 * fq) * 2048 + h * 512 + sl * 32 + (w >> 2) * 16 + fr;      \
              _Pragma("unroll") for (int i = 0; i < 4; ++i) op_[(size_t)i * 2048] = (bf16_t)f2bf(acc[i]); } } while (0)
#pragma unroll 1
        for (int n = 0; n < NCHUNK - 1; n += 3) {
            SCAN_STEP(oa, ob, oc, n);
            SCAN_STEP(ob, oc, oa, n + 1);
            SCAN_STEP(oc, oa, ob, n + 2);
        }
        SCAN_STEP(oa, ob, oc, NCHUNK - 1);
#undef SCAN_STEP
    }
}
__device__ __forceinline__ void ph_gla_final(const Args& a, int bid, int nblk) {
    unsigned char* ws = a.ws; const int tid = threadIdx.x, lane = tid & 63, wave = __builtin_amdgcn_readfirstlane(tid >> 6);
    const bf16_t* GV = (const bf16_t*)((unsigned char*)a.out + DO_GV); bf16_t* GR = (bf16_t*)(ws + WS_GR); const float* ng = a.in[I_NG];
    for (int it = bid * 8 + wave; it < M * 4; it += nblk * 8) { const size_t off = (size_t)(it >> 2) * 2048 + (it & 3) * 512 + 8 * lane;
        f32x4 o0, o1, r0, r1; unpack8(*(const u32x4*)(GV + off), o0, o1); unpack8(*(const u32x4*)(GR + off), r0, r1);
        float ss = (o0[0] * o0[0] + o0[1] * o0[1]) + (o0[2] * o0[2] + o0[3] * o0[3]) + (o1[0] * o1[0] + o1[1] * o1[1]) + (o1[2] * o1[2] + o1[3] * o1[3]);
        ss = wave_sum(ss); const float rs = 1.0f / sqrtf(ss * (1.0f / 512.0f) + RMS_EPS);
        const f32x4 g0 = *(const f32x4*)(ng + (it & 3) * 512 + 8 * lane), g1 = *(const f32x4*)(ng + (it & 3) * 512 + 8 * lane + 4);
#pragma unroll
        for (int j = 0; j < 4; ++j) { o0[j] = o0[j] * rs * g0[j] * (r0[j] / (1.f + __expf(-r0[j]))); o1[j] = o1[j] * rs * g1[j] * (r1[j] / (1.f + __expf(-r1[j]))); }
        *(u32x2*)((unsigned char*)a.out + DO_OGQ + off) = (u32x2){pk_fp8x4(o0[0], o0[1], o0[2], o0[3]), pk_fp8x4(o1[0], o1[1], o1[2], o1[3])}; }
    { const bf16_t* QDM = (const bf16_t*)(ws + WS_QDM); unsigned char* dq = (unsigned char*)a.out + DO_ODMQ;
      for (size_t i = (size_t)bid * 512 + tid; i < (size_t)M * 2048 / 8; i += (size_t)nblk * 512) { f32x4 p, q; unpack8(((const u32x4*)QDM)[i], p, q);
          const float sc = ((i & 255) >= 128) ? OMEM_SCALE : 1.0f;
          ((u32x2*)dq)[i] = (u32x2){pk_fp8x4(p[0] * sc, p[1] * sc, p[2] * sc, p[3] * sc), pk_fp8x4(q[0] * sc, q[1] * sc, q[2] * sc, q[3] * sc)}; } }
}

__device__ __forceinline__ void ph_dsa_norms(const Args& a, LAS unsigned char* lds, int bid, int nblk) {
    unsigned char* ws = a.ws; const int tid = threadIdx.x, lane = tid & 63, wave = __builtin_amdgcn_readfirstlane(tid >> 6);
    LAS float* wmax = (LAS float*)lds; LAS int* wid = (LAS int*)(lds + 256);
    for (int c0 = bid * 8; c0 < 2 * M / 32; c0 += nblk * 8) { const int chunk = c0 + wave; const int which = chunk >= M / 32, r0 = (which ? chunk - M / 32 : chunk) * 32, b = r0 / T;
        float mx = 0.f;
        for (int r = 0; r < 32; ++r) { const int row = r0 + r;
            const bf16_t* src = which ? (const bf16_t*)(ws + WS_DK) + (size_t)row * 1024 : (const bf16_t*)(ws + WS_QDM) + (size_t)row * 2048;
            f32x4 v0, v1, v2, v3; unpack8(*(const u32x4*)(src + 16 * lane), v0, v1); unpack8(*(const u32x4*)(src + 16 * lane + 8), v2, v3);
            const float ss = (v0[0] * v0[0] + v0[1] * v0[1]) + (v0[2] * v0[2] + v0[3] * v0[3]) + (v1[0] * v1[0] + v1[1] * v1[1]) + (v1[2] * v1[2] + v1[3] * v1[3])
                           + (v2[0] * v2[0] + v2[1] * v2[1]) + (v2[2] * v2[2] + v2[3] * v2[3]) + (v3[0] * v3[0] + v3[1] * v3[1]) + (v3[2] * v3[2] + v3[3] * v3[3]);
            float t = ss + __shfl_xor(ss, 1); t += __shfl_xor(t, 2); t += __shfl_xor(t, 4); mx = fmaxf(mx, t); }
        if ((lane & 7) == 0) wmax[wave * 8 + (lane >> 3)] = mx;
        if (lane == 0) wid[wave] = which * 2 + b;
        __syncthreads();
        if (tid < 32) { const int id = tid >> 3, h = tid & 7; float m = 0.f; bool any = false;
#pragma unroll
            for (int w = 0; w < 8; ++w) if (wid[w] == id) { m = fmaxf(m, wmax[w * 8 + h]); any = true; }
            if (any) __hip_atomic_fetch_max((unsigned*)(ws + WS_CTL) + CW_NRM + ((id & 1) * 8 + h) * 2 + (id >> 1), __builtin_bit_cast(unsigned, m), __ATOMIC_RELAXED, __HIP_MEMORY_SCOPE_AGENT); }
        __syncthreads();
    }
}
__device__ __forceinline__ int binf(float x, float lo, float iw) { int b = (int)((x - lo) * iw); b = b < 0 ? 0 : b; return b > 511 ? 511 : b; }
typedef _Float16 f16x8 __attribute__((ext_vector_type(8)));
__device__ __forceinline__ void ph_dsa_index(const Args& a, LAS unsigned char* lds, int bid, int nblk) {
    unsigned char* ws = a.ws; const int tid = threadIdx.x, lane = tid & 63, wave = __builtin_amdgcn_readfirstlane(tid >> 6);
    LAS _Float16* sc = (LAS _Float16*)lds;
    LAS unsigned* hist = (LAS unsigned*)(lds + 131072);
    LAS unsigned* mwl = (LAS unsigned*)(lds + 139264);
    LAS unsigned* cand_s = (LAS unsigned*)(lds + 147456);
    LAS float* cand_x = (LAS float*)(lds + 151552);
    LAS unsigned* misc = (LAS unsigned*)(lds + 155648);
    LAS float* part = (LAS float*)(lds + 156160);
    LAS _Float16* dummy = (LAS _Float16*)(lds + 156416) + lane;
    const bf16_t* IQ = (const bf16_t*)(ws + WS_IQ); const bf16_t* IKB = (const bf16_t*)(ws + WS_IKB); const float* SMF = (const float*)(ws + WS_SMF);
    unsigned long long* MASK = (unsigned long long*)(ws + WS_SEL);
    const int hi = lane >> 5, c = lane & 31; const float INF = __builtin_inff();
    for (int it = bid; it < M / 4; it += nblk) {
        const int b = it & 1, j = it >> 1, jj = j >> 7, jl = j & 127, pl = (jj >> 1) * 128 + jl, p = (jj & 1) ? (T / 4 - 1 - pl) : pl, t0 = 4 * p; const size_t row0 = (size_t)b * T + t0;
        {
            const int qsel = (c >> 2) & 1, g = (c & 3) + 4 * (c >> 3);
            bf16x8 af0[4], af1[4];
#pragma unroll
            for (int kk = 0; kk < 4; ++kk) { af0[kk] = *(const bf16x8*)(IQ + (row0 + qsel) * 1024 + g * 64 + 16 * kk + 8 * hi); af1[kk] = *(const bf16x8*)(IQ + (row0 + 2 + qsel) * 1024 + g * 64 + 16 * kk + 8 * hi); }
            float wv0[16], wv1[16];
#pragma unroll
            for (int i = 0; i < 16; ++i) { wv0[i] = SMF[(row0 + hi) * 256 + 64 + i] * 0.03125f; wv1[i] = SMF[(row0 + 2 + hi) * 256 + 64 + i] * 0.03125f; }
            const int ntile = (t0 + 4 + 31) >> 5, tq0 = t0 + hi, tq1 = t0 + 2 + hi, ngrp = (ntile + 15) >> 4;
            const bf16_t* kp0 = IKB + (size_t)b * (T / 32) * 2048 + lane * 8;
            float smax0 = -INF, smin0 = INF, smax1 = -INF, smin1 = INF;
#define D1_LOAD(F, g) do { _Pragma("unroll") for (int u = 0; u < 2; ++u) { int tile = 16 * (g) + wave + 8 * u; if (tile >= ntile) tile = 0; const bf16_t* kp = kp0 + (size_t)tile * 2048; \
                _Pragma("unroll") for (int kk = 0; kk < 4; ++kk) F[u][kk] = *(const bf16x8*)(kp + 512 * kk); } } while (0)
#define D1_ROWS(AF, WV, TQ, SMAX, SMIN, ROWP) do { f32x16 acc; _Pragma("unroll") for (int i = 0; i < 16; ++i) acc[i] = 0.f; \
                _Pragma("unroll") for (int kk = 0; kk < 4; ++kk) acc = __builtin_amdgcn_mfma_f32_32x32x16_bf16(AF[kk], Fu[kk], acc, 0, 0, 0); \
                float s_ = 0.f; _Pragma("unroll") for (int i = 0; i < 16; ++i) { const float av = acc[i]; const int ri = __float_as_int(av); s_ += WV[i] * __int_as_float(ri > 0 ? ri : 0); }     \
                const _Float16 sh = (_Float16)s_; const float sr = (float)sh; const bool ok = s <= (tv ? TQ : -1); SMAX = ok ? fmaxf(SMAX, sr) : SMAX; SMIN = ok ? fminf(SMIN, sr) : SMIN; \
                LAS _Float16* dst = tv ? sc + ((ROWP) + hi) * 16384 + s : dummy; *dst = sh; } while (0)
#define D1_COMP(F, g) do { _Pragma("unroll") for (int u = 0; u < 2; ++u) { const int tile = 16 * (g) + wave + 8 * u; const bool tv = tile < ntile; const int s = tile * 32 + c; const bf16x8 (&Fu)[4] = F[u]; \
                D1_ROWS(af0, wv0, tq0, smax0, smin0, 0); D1_ROWS(af1, wv1, tq1, smax1, smin1, 2); } } while (0)
            bf16x8 fa[2][4], fb[2][4];
            D1_LOAD(fa, 0);
#pragma unroll 1
            for (int g2 = 0; g2 < ngrp; g2 += 2) {
                D1_LOAD(fb, g2 + 1);
                D1_COMP(fa, g2);
                D1_LOAD(fa, g2 + 2);
                D1_COMP(fb, g2 + 1);
            }
#undef D1_LOAD
#undef D1_ROWS
#undef D1_COMP
#pragma unroll
            for (int o = 1; o < 32; o <<= 1) { smax0 = fmaxf(smax0, __shfl_xor(smax0, o)); smin0 = fminf(smin0, __shfl_xor(smin0, o)); smax1 = fmaxf(smax1, __shfl_xor(smax1, o)); smin1 = fminf(smin1, __shfl_xor(smin1, o)); }
            if (c == 0) { part[(wave * 4 + hi) * 2] = smax0; part[(wave * 4 + hi) * 2 + 1] = smin0; part[(wave * 4 + 2 + hi) * 2] = smax1; part[(wave * 4 + 2 + hi) * 2 + 1] = smin1; }
        }
        const int q = tid >> 7, t4 = tid & 127, w4 = (tid >> 6) & 1, nk = t0 + q + 1;
        LAS _Float16* scq = sc + q * 16384; LAS unsigned* hq = hist + q * 512; LAS unsigned* mwq = mwl + q * 512; LAS unsigned* cs = cand_s + q * 256; LAS float* cx = cand_x + q * 256;
        LAS unsigned* mq = misc + q * 32; LAS float* mqf = (LAS float*)mq;
#pragma unroll
        for (int e = 0; e < 4; ++e) mwq[t4 + 128 * e] = 0u;
        unsigned nearv = 0u;
        if (t4 == 0) { mq[7] = 0u; mq[26] = 1u; mq[27] = 0u; }
        __syncthreads();
#define D1_MARK(s) do { __hip_atomic_fetch_or(mwq + ((s) >> 5), 1u << ((s) & 31), __ATOMIC_RELAXED, __HIP_MEMORY_SCOPE_WORKGROUP); nearv = nearv > (unsigned)(s) ? nearv : (unsigned)(s); } while (0)
        if (t0 + 4 <= 256) {
            for (int s = t4; s < nk; s += 128) D1_MARK(s);
        } else {
            float lo = INF, hiv = -INF;
#pragma unroll
            for (int w = 0; w < 8; ++w) { hiv = fmaxf(hiv, part[(w * 4 + q) * 2]); lo = fminf(lo, part[(w * 4 + q) * 2 + 1]); }
            unsigned k = 256u; int nlev = 0; bool active = true; float lo0 = 0.f, iw0 = 0.f; int B0 = 0;
            const int nk8 = (nk + 7) >> 3;
#pragma unroll 1
            for (int lev = 0; lev < 6; ++lev) {
                const float iw = 512.f / (hiv - lo);
                if (active) {
#pragma unroll
                    for (int e = 0; e < 4; ++e) hq[t4 + 128 * e] = 0u; }
                __syncthreads();
                if (active) {
                    for (int i8 = t4; i8 < nk8; i8 += 128) { const f16x8 xv = *(const LAS f16x8*)(scq + 8 * i8);
#pragma unroll
                        for (int e = 0; e < 8; ++e) { const int s = 8 * i8 + e; const float x = (float)xv[e]; bool cnd = s < nk;
                            for (int l = 0; l < lev && cnd; ++l) cnd = binf(x, mqf[8 + l], mqf[14 + l]) == (int)mq[20 + l];
                            if (cnd) __hip_atomic_fetch_add(hq + binf(x, lo, iw), 1u, __ATOMIC_RELAXED, __HIP_MEMORY_SCOPE_WORKGROUP); } }
                }
                __syncthreads();
                unsigned cb[4] = {0u, 0u, 0u, 0u}, v = 0u;
                if (active) {
#pragma unroll
                    for (int e = 0; e < 4; ++e) { cb[e] = hq[4 * t4 + e]; v += cb[e]; }
#pragma unroll
                    for (int off = 1; off < 64; off <<= 1) { const unsigned x = __shfl_down(v, off); if (lane + off < 64) v += x; }
                    if (lane == 0) mq[w4] = v; }
                __syncthreads();
                if (active) { unsigned above = v - (cb[0] + cb[1] + cb[2] + cb[3]); if (w4 == 0) above += mq[1];
#pragma unroll
                    for (int e = 3; e >= 0; --e) { if (above < k && k <= above + cb[e]) { mq[4] = (unsigned)(4 * t4 + e); mq[5] = k - above; mq[6] = cb[e]; } above += cb[e]; } }
                __syncthreads();
                if (active) { const int B = (int)mq[4]; k = mq[5]; const unsigned cB = mq[6];
                    if (lev == 0) { lo0 = lo; iw0 = iw; B0 = B; }
                    if (t4 == 0) { mqf[8 + lev] = lo; mqf[14 + lev] = iw; mq[20 + lev] = (unsigned)B; }
                    nlev = lev + 1;
                    const float wdt = (hiv - lo) * (1.0f / 512.0f), nlo = lo + ((float)B - 0.01f) * wdt, nhi = lo + ((float)B + 1.01f) * wdt; lo = nlo; hiv = nhi;
                    if (cB <= 256u || !(hiv > lo)) { active = false; if (t4 == 0) mq[26] = 0u; } }
                __syncthreads();
                if ((misc[26] | misc[32 + 26] | misc[64 + 26] | misc[96 + 26]) == 0u) break;
            }
            for (int i8 = t4; i8 < nk8; i8 += 128) { const f16x8 xv = *(const LAS f16x8*)(scq + 8 * i8);
#pragma unroll
                for (int e = 0; e < 8; ++e) { const int s = 8 * i8 + e; const float x = (float)xv[e];
                    if (s < nk) { int b0 = binf(x, lo0, iw0), cls = b0 > B0 ? 1 : (b0 < B0 ? -1 : 0);
                        for (int l = 1; l < nlev && cls == 0; ++l) { const int bl = binf(x, mqf[8 + l], mqf[14 + l]), Bl = (int)mq[20 + l]; cls = bl > Bl ? 1 : (bl < Bl ? -1 : 0); }
                        if (cls > 0) D1_MARK(s);
                        else if (cls == 0) { const unsigned pos = __hip_atomic_fetch_add(mq + 7, 1u, __ATOMIC_RELAXED, __HIP_MEMORY_SCOPE_WORKGROUP); if (pos < 256u) { cs[pos] = (unsigned)s; cx[pos] = x; } } } } }
            __syncthreads();
            const unsigned cc = mq[7];
            if (cc <= 256u) {
                for (unsigned ci = (unsigned)t4; ci < cc; ci += 128u) { const float xi = cx[ci]; const unsigned si = cs[ci]; unsigned rank = 0u;
                    for (unsigned jx = 0; jx < cc; ++jx) { const float xj = cx[jx]; const unsigned sj = cs[jx]; rank += (xj > xi || (xj == xi && sj < si)) ? 1u : 0u; }
                    if (rank < k) D1_MARK(si); }
            } else if (t4 == 0) {
                unsigned left = k;
                for (int s = 0; s < nk && left; ++s) { const float x = (float)scq[s]; int cls = 0;
                    for (int l = 0; l < nlev && cls == 0; ++l) { const int bl = binf(x, mqf[8 + l], mqf[14 + l]), Bl = (int)mq[20 + l]; cls = bl > Bl ? 1 : (bl < Bl ? -1 : 0); }
                    if (cls == 0) { D1_MARK(s); --left; } } }
        }
#undef D1_MARK
#pragma unroll
        for (int o = 1; o < 64; o <<= 1) { const unsigned x = __shfl_xor(nearv, o); nearv = nearv > x ? nearv : x; }
        if (lane == 0) __hip_atomic_fetch_max(mq + 27, nearv, __ATOMIC_RELAXED, __HIP_MEMORY_SCOPE_WORKGROUP);
        __syncthreads();
        { const int jmax = ((t0 >> 8) + 1) * 4;
          for (int jt = t4; jt < jmax; jt += 128) MASK[((size_t)b * 256 + jt) * T + t0 + q] = (unsigned long long)mwq[2 * jt] | ((unsigned long long)mwq[2 * jt + 1] << 32);
          if (t4 == 0) __hip_atomic_fetch_max((unsigned*)(ws + WS_CTL) + CW_DNB + b * 64 + ((t0 + q) >> 8), (unsigned)(t0 + q) - mq[27], __ATOMIC_RELAXED, __HIP_MEMORY_SCOPE_AGENT); }
        __syncthreads();
    }
}
__device__ __forceinline__ int crow(int r, int hi) { return (r & 3) + 8 * (r >> 2) + 4 * hi; }
namespace dsa {
constexpr int DH = 128, PQ = 2048, PKV = 1024, NW = 8, QBLK = 32, KVBLK = 64, QB = NW * QBLK;
constexpr int SHM_V = KVBLK * DH * 2, SHM_K = KVBLK * DH * 2, LDS_NEED = 2 * SHM_V + 2 * SHM_K + NW * 64 * 4;
constexpr float SCALE = 0.08838834764831845f, THR = 8.f;
#define KSWZ(row, colB) ((row) * 256 + ((colB) ^ (((row) & 7) << 4)))
#define SBAR() __builtin_amdgcn_sched_barrier(0)
__device__ __forceinline__ int v_st(int k, int c) { const int kk = (k & ~0xC) | ((k & 4) << 1) | ((k & 8) >> 1); return ((kk >> 3) * 4 + (c >> 5)) * 512 + ((kk & 7) * 32 + (c & 31)) * 2; }
__device__ __forceinline__ int v_rd_base(int lane) { return ((lane & 3) << 3) | (((lane >> 2) & 3) << 6) | (((lane >> 4) & 1) << 5) | (((lane >> 5) & 1) << 8); }
constexpr int v_rd_off(int d0, int ks, int half) { return d0 * 512 + ks * 4096 + half * 2048; }
typedef short s16x4 __attribute__((ext_vector_type(4)));
__device__ __forceinline__ bf16x8 ld8(const bf16_t* p) { return *reinterpret_cast<const bf16x8*>(p); }
__device__ __forceinline__ void partialSM(f32x16& p0, f32x16& p1, float& m_reg, float& mn, float& alpha) {
    float pmax = p0[0]; for (int r = 1; r < 16; ++r) pmax = fmaxf(pmax, p0[r]); for (int r = 0; r < 16; ++r) pmax = fmaxf(pmax, p1[r]);
    { auto rr = __builtin_amdgcn_permlane32_swap(__float_as_uint(pmax), __float_as_uint(pmax), false, false);
      pmax = fmaxf(__uint_as_float(rr[0]), __uint_as_float(rr[1])); }
    constexpr float C2 = 1.4426950408889634f * SCALE;
    if (__builtin_expect(__all((pmax - m_reg) * SCALE <= THR), 1)) { mn = m_reg; alpha = 1.f; }
    else { mn = fmaxf(m_reg, pmax); alpha = __builtin_amdgcn_exp2f((m_reg - mn) * C2); m_reg = mn; }
    const float mnL = -mn * C2;
    for (int r = 0; r < 16; ++r) p0[r] = fmaf(p0[r], C2, mnL); for (int r = 0; r < 16; ++r) p1[r] = fmaf(p1[r], C2, mnL);
    for (int r = 0; r < 16; ++r) p0[r] = __builtin_amdgcn_exp2f(p0[r]);
}
__device__ __forceinline__ void finishSM(f32x16& p0, f32x16& p1, float alpha, float& l_reg, bf16x8& pa0, bf16x8& pa1, bf16x8& pa2, bf16x8& pa3) {
    for (int r = 0; r < 16; ++r) p1[r] = __builtin_amdgcn_exp2f(p1[r]);
    float ps = 0; for (int r = 0; r < 16; ++r) ps += p0[r]; for (int r = 0; r < 16; ++r) ps += p1[r];
    { auto rr = __builtin_amdgcn_permlane32_swap(__float_as_uint(ps), __float_as_uint(ps), false, false);
      ps = __uint_as_float(rr[0]) + __uint_as_float(rr[1]); }
    l_reg = l_reg * alpha + ps;
#define PK4(P, B_, OUT) do { unsigned a0 = cvt_pk_bf16(P[B_+0], P[B_+1]), a1 = cvt_pk_bf16(P[B_+2], P[B_+3]);                          \
        unsigned b0 = cvt_pk_bf16(P[B_+4], P[B_+5]), b1 = cvt_pk_bf16(P[B_+6], P[B_+7]);                                             \
        auto r0 = __builtin_amdgcn_permlane32_swap(a0, b0, false, false); auto r1 = __builtin_amdgcn_permlane32_swap(a1, b1, false, false); \
        u32x4 w = {r0[0], r1[0], r0[1], r1[1]}; OUT = *reinterpret_cast<bf16x8*>(&w); } while (0)
    PK4(p0, 0, pa0); PK4(p0, 8, pa1); PK4(p1, 0, pa2); PK4(p1, 8, pa3);
#undef PK4
}
template <int KB>
__device__ __forceinline__ void qkt(f32x16& p0, f32x16& p1, const char* K_lds, int r32, int hi, const bf16x8* qr, u32x2 mw, float base0, float slr) {
    const float NEG = -__builtin_inff(); const unsigned wl = mw.x >> (4 * hi), wh = mw.y >> (4 * hi); const float base1 = fmaf(32.f, slr, base0);
#pragma unroll
    for (int r = 0; r < 16; ++r) { const int cr = (r & 3) + 8 * (r >> 2);
        p0[r] = ((wl >> cr) & 1u) ? fmaf(slr, (float)cr, base0) : NEG; p1[r] = ((wh >> cr) & 1u) ? fmaf(slr, (float)cr, base1) : NEG; }
    const char* kb[4];
#pragma unroll
    for (int dd = 0; dd < 4; ++dd) kb[dd] = K_lds + KB * SHM_K + KSWZ(r32, (dd * 16 + hi * 8) * 2);
#pragma unroll
    for (int d0 = 0; d0 < 8; ++d0) { const char* a = kb[d0 & 3] + (d0 >> 2) * 128;
        bf16x8 b0 = *reinterpret_cast<const bf16x8*>(a);
        bf16x8 b1 = *reinterpret_cast<const bf16x8*>(a + 32 * 256);
        p0 = __builtin_amdgcn_mfma_f32_32x32x16_bf16(b0, qr[d0], p0, 0, 0, 0);
        p1 = __builtin_amdgcn_mfma_f32_32x32x16_bf16(b1, qr[d0], p1, 0, 0, 0); }
}
template <int VB>
__device__ __forceinline__ void pv_tile(f32x16* o, int vb0, bf16x8 pa0, bf16x8 pa1, bf16x8 pa2, bf16x8 pa3) {
#define TRRD(dst, off) asm volatile("ds_read_b64_tr_b16 %0, %1 offset:%2" : "=&v"(dst) : "v"(vb0), "i"(off) : "memory")
#define PV_D0(d0) do { s16x4 l0, l1, l2, l3, h0, h1, h2, h3; constexpr int b_ = VB * SHM_V + v_rd_off(d0, 0, 0); \
        TRRD(l0, b_); TRRD(h0, b_ + 2048); TRRD(l1, b_ + 4096); TRRD(h1, b_ + 6144); TRRD(l2, b_ + 8192); TRRD(h2, b_ + 10240); TRRD(l3, b_ + 12288); TRRD(h3, b_ + 14336); \
        asm volatile("s_waitcnt lgkmcnt(0)" ::: "memory"); SBAR();   \
        o[d0] = __builtin_amdgcn_mfma_f32_32x32x16_bf16(pa0, (bf16x8){l0[0], l0[1], l0[2], l0[3], h0[0], h0[1], h0[2], h0[3]}, o[d0], 0, 0, 0);   \
        o[d0] = __builtin_amdgcn_mfma_f32_32x32x16_bf16(pa1, (bf16x8){l1[0], l1[1], l1[2], l1[3], h1[0], h1[1], h1[2], h1[3]}, o[d0], 0, 0, 0);   \
        o[d0] = __builtin_amdgcn_mfma_f32_32x32x16_bf16(pa2, (bf16x8){l2[0], l2[1], l2[2], l2[3], h2[0], h2[1], h2[2], h2[3]}, o[d0], 0, 0, 0);   \
        o[d0] = __builtin_amdgcn_mfma_f32_32x32x16_bf16(pa3, (bf16x8){l3[0], l3[1], l3[2], l3[3], h3[0], h3[1], h3[2], h3[3]}, o[d0], 0, 0, 0); } while (0)
    PV_D0(0); PV_D0(1); PV_D0(2); PV_D0(3);
#undef PV_D0
#undef TRRD
}
struct BlockRef { const bf16_t* Q; const bf16_t* K; const bf16_t* V; bf16_t* O; const unsigned long long* MW; int P0; float slr; int jlo; };
struct Seam { bf16x8 qr[8]; bf16x8 st_v0, st_v1, st_k0, st_k1; u32x2 mwA; };
#define ROWK(p, k0, rr) ((p) + (size_t)((k0) + (rr)) * PKV + sc)
#define VMW() asm volatile("s_waitcnt vmcnt(0)" ::: "memory")
#define VMWN(n) asm volatile("s_waitcnt vmcnt(%0)" :: "i"(n) : "memory")
#define SLOAD_H(Kp, Vp, k0) do { S.st_v0 = ld8(ROWK(Vp, k0, sr)); S.st_v1 = ld8(ROWK(Vp, k0, 32 + sr)); S.st_k0 = ld8(ROWK(Kp, k0, sr)); S.st_k1 = ld8(ROWK(Kp, k0, 32 + sr)); } while (0)
#define SWRITE_HK(bf) do { *(bf16x8*)(K_lds + (bf) * SHM_K + kws) = S.st_k0; *(bf16x8*)(K_lds + (bf) * SHM_K + kws + 32 * 256) = S.st_k1; } while (0)
#define SWRITE_HV(bf) do { *(bf16x8*)(V_lds + (bf) * SHM_V + vst0) = S.st_v0; *(bf16x8*)(V_lds + (bf) * SHM_V + vst1) = S.st_v1; } while (0)
#define SWRITE_H(bf) do { SWRITE_HV(bf); SWRITE_HK(bf); } while (0)
#define MLOAD(ref, j, rowpos) (*(const u32x2*)((ref).MW + (size_t)(j) * T + (rowpos)))
__device__ __forceinline__ void prime(const BlockRef& cur, char* lds, Seam& S) {
    const int tid = threadIdx.x, wid = __builtin_amdgcn_readfirstlane(tid >> 6), lane = tid & 63, r32 = lane & 31, hi = lane >> 5;
    const int sr = tid >> 4, sc = (tid & 15) * 8, kws = KSWZ(sr, sc * 2); char* K_lds = lds + 2 * SHM_V;
#pragma unroll
    for (int d0 = 0; d0 < 8; ++d0) S.qr[d0] = ld8(cur.Q + (size_t)(wid * QBLK + r32) * PQ + d0 * 16 + hi * 8);
    SLOAD_H(cur.K, cur.V, cur.jlo * KVBLK); S.mwA = MLOAD(cur, cur.jlo, cur.P0 + wid * QBLK + r32); VMW(); SWRITE_HK(0);
    __syncthreads();
}
template <class NextFn>
__device__ __forceinline__ BlockRef block(const BlockRef& cur, const NextFn& next_ref, char* lds, Seam& S) {
    const int tid = threadIdx.x, wid = __builtin_amdgcn_readfirstlane(tid >> 6), lane = tid & 63, r32 = lane & 31, hi = lane >> 5;
    const int jlo = cur.jlo, NT = cur.P0 / KVBLK + 4 - jlo;
    const int tposq = cur.P0 + wid * QBLK + r32; const float slr = cur.slr, f0 = -slr * (float)(tposq - 4 * hi);
    char* V_lds = lds; char* K_lds = lds + 2 * SHM_V;
    float* wsf = (float*)(lds + 2 * SHM_V + 2 * SHM_K) + wid * 64; float* li_l = wsf, * al_l = wsf + 32;
    float m_reg = -1e30f, l_reg = 0; f32x16 o[4] = {};
    const int sr = tid >> 4, sc = (tid & 15) * 8, vst0 = v_st(sr, sc), vst1 = v_st(32 + sr, sc), kws = KSWZ(sr, sc * 2);
    const int vb0 = (int)(uintptr_t)V_lds + v_rd_base(lane);
    const bf16_t* Kh = cur.K; const bf16_t* Vh = cur.V;
#define RESC(a) do { if (__any((a) < 1.f)) { if (hi == 0) al_l[r32] = (a); asm volatile("s_waitcnt lgkmcnt(0)" ::: "memory");              \
                     for (int d_ = 0; d_ < 4; ++d_) for (int r = 0; r < 16; ++r) o[d_][r] *= al_l[crow(r, hi)]; } } while (0)
#define KBASE(t) ((jlo + (t)) * KVBLK)
#define BASE0(t) fmaf(slr, (float)KBASE(t), f0)
    f32x16 pA0, pA1, pB0, pB1; float mnA, mnB, alA, alB; bf16x8 pa0, pa1, pa2, pa3; u32x2 mwB;
    SWRITE_HV(0); SBAR();
    SLOAD_H(Kh, Vh, KBASE(1)); mwB = MLOAD(cur, jlo + 1, tposq);
    SBAR(); qkt<0>(pA0, pA1, K_lds, r32, hi, S.qr, S.mwA, BASE0(0), slr);
    partialSM(pA0, pA1, m_reg, mnA, alA);
    VMW(); SWRITE_H(1);
    __syncthreads();
#define HALF_STEP(PX0, PX1, mnX, alX, PY0, PY1, alY, t, KB, VB, SB, MWX, MWY) do {                                          \
        SBAR(); qkt<KB>(PX0, PX1, K_lds, r32, hi, S.qr, MWX, BASE0(t), slr);                                                \
        finishSM(PY0, PY1, alY, l_reg, pa0, pa1, pa2, pa3); SBAR();                                                           \
        if ((t) + 1 < NT) { SLOAD_H(Kh, Vh, KBASE((t) + 1)); MWY = MLOAD(cur, jlo + (t) + 1, tposq); SBAR(); }                   \
        pv_tile<VB>(o, vb0, pa0, pa1, pa2, pa3); partialSM(PX0, PX1, m_reg, mnX, alX);                                      \
        __syncthreads();                                                                                                      \
        if ((t) + 1 < NT) { VMW(); SWRITE_H(SB); }                                                                           \
        RESC(alX); __syncthreads(); } while (0)
    for (int t = 1; t + 1 < NT; t += 2) {
        HALF_STEP(pB0, pB1, mnB, alB, pA0, pA1, alA, t, 1, 0, 0, mwB, S.mwA);
        HALF_STEP(pA0, pA1, mnA, alA, pB0, pB1, alB, t + 1, 0, 1, 1, S.mwA, mwB);
    }
    SBAR(); qkt<1>(pB0, pB1, K_lds, r32, hi, S.qr, mwB, BASE0(NT - 1), slr); SBAR();
    const BlockRef nxt = next_ref(cur);
    SLOAD_H(nxt.K, nxt.V, nxt.jlo * KVBLK); S.mwA = MLOAD(nxt, nxt.jlo, nxt.P0 + wid * QBLK + r32); SBAR();
#pragma unroll
    for (int d0 = 0; d0 < 8; ++d0) S.qr[d0] = ld8(nxt.Q + (size_t)(wid * QBLK + r32) * PQ + d0 * 16 + hi * 8);
    SBAR();
    finishSM(pA0, pA1, alA, l_reg, pa0, pa1, pa2, pa3); SBAR();
    pv_tile<0>(o, vb0, pa0, pa1, pa2, pa3);
    partialSM(pB0, pB1, m_reg, mnB, alB); __syncthreads(); RESC(alB);
    finishSM(pB0, pB1, alB, l_reg, pa0, pa1, pa2, pa3); SBAR(); pv_tile<1>(o, vb0, pa0, pa1, pa2, pa3);
    SBAR(); VMWN(8); SWRITE_HK(0); SBAR();
    if (hi == 0) li_l[r32] = l_reg; asm volatile("s_waitcnt lgkmcnt(0)" ::: "memory");
    float rli[16];
#pragma unroll
    for (int r = 0; r < 16; ++r) rli[r] = __builtin_amdgcn_rcpf(li_l[crow(r, hi)]);
    bf16_t* Ow = cur.O + (size_t)(wid * QBLK) * PQ;
#pragma unroll
    for (int r = 0; r < 16; ++r) { const int orow = crow(r, hi);
#pragma unroll
        for (int d0 = 0; d0 < 4; ++d0) { const float v = o[d0][r] * rli[r]; const float vn = __shfl_xor(v, 1);
            if ((r32 & 1) == 0) *(unsigned*)(Ow + (size_t)orow * PQ + d0 * 32 + r32) = cvt_pk_bf16(v, vn); } }
    __syncthreads();
    return nxt;
#undef RESC
#undef KBASE
#undef BASE0
#undef HALF_STEP
}
#undef ROWK
#undef VMW
#undef VMWN
#undef SLOAD_H
#undef SWRITE_HK
#undef SWRITE_HV
#undef SWRITE_H
#undef MLOAD
}
__device__ __forceinline__ dsa::BlockRef dsa_ref(unsigned char* ws, int i) {
    const int qb = 63 - (i >> 4), h = 7 - ((i & 15) >> 1), b = i & 1;
    dsa::BlockRef r; bf16_t* q = (bf16_t*)(ws + WS_QDM) + ((size_t)b * T + (size_t)qb * 256) * 2048 + h * 128;
    r.Q = q; r.O = q; r.K = (const bf16_t*)(ws + WS_DK) + (size_t)b * T * 1024 + h * 128; r.V = (const bf16_t*)(ws + WS_DV) + (size_t)b * T * 1024 + h * 128;
    r.MW = (const unsigned long long*)(ws + WS_SEL) + (size_t)b * 256 * T; r.P0 = qb * 256;
    const float slope = exp2f(-(float)(h + 1)); r.slr = slope * 11.313708498984761f;
    const unsigned* ctl = (const unsigned*)(ws + WS_CTL);
    const float q2 = __builtin_bit_cast(float, ctl[CW_NRM + (b * 8 + h) * 2]), k2 = __builtin_bit_cast(float, ctl[CW_NRM + (b * 8 + h) * 2 + 1]);
    const float dextra = (2.f * sqrtf(q2 * k2) * dsa::SCALE * 1.01f + 28.f) / slope + 2.f;
    const float lowest = (float)r.P0 - (float)ctl[CW_DNB + b * 64 + qb] - dextra;
    int jlo = lowest > 0.f ? (int)(lowest * (1.0f / 64.0f)) : 0; if (jlo & 1) jlo -= 1;
    r.jlo = jlo;
    return r;
}
struct DsaNext { unsigned char* ws; volatile int* slot;
    __device__ __forceinline__ dsa::BlockRef operator()(const dsa::BlockRef& cur) const { const int i = __builtin_amdgcn_readfirstlane(*slot); return i < 1024 ? dsa_ref(ws, i) : cur; } };
__device__ __forceinline__ void ph_dsa_attn(const Args& a, char* lds, int bid, int nblk) {
    volatile int* slot = (volatile int*)(lds + dsa::LDS_NEED + 64);
    unsigned* qhead = (unsigned*)(a.ws + WS_CTL) + CW_QHEAD;
    if (threadIdx.x == 0) *slot = (int)__hip_atomic_fetch_add(qhead, 1u, __ATOMIC_RELAXED, __HIP_MEMORY_SCOPE_AGENT);
    __syncthreads();
    int i = __builtin_amdgcn_readfirstlane(*slot); if (i >= 1024) return;
    dsa::BlockRef cur = dsa_ref(a.ws, i);
    dsa::Seam S; dsa::prime(cur, lds, S);
    const DsaNext nf{a.ws, slot};
    for (;;) {
        if (threadIdx.x == 0) *slot = (int)__hip_atomic_fetch_add(qhead, 1u, __ATOMIC_RELAXED, __HIP_MEMORY_SCOPE_AGENT);
        const dsa::BlockRef nxt = dsa::block(cur, nf, lds, S);
        i = __builtin_amdgcn_readfirstlane(*slot);
        __syncthreads();
        if (i >= 1024) break;
        cur = nxt;
    }
}

namespace memat {
constexpr int KB_PITCH = 528, KB_BYTES = 32 * KB_PITCH, VB_PITCH = 72, VB_BYTES = 128 * VB_PITCH;
template <bool MAXP>
__device__ __forceinline__ void pass(LAS unsigned char* Kb, LAS unsigned char* Vb, const bf16_t* kg, const bf16_t* vg, const bf16x8 (&qf)[16], float& mx, float mneg, f32x16 (&o)[4], float& l,
                                     int tid, int r32, int hi) {
    const float c2 = 0.0625f * 1.4426950408889634f;
    const int kkey = tid >> 4, kseg = tid & 15, vd = tid >> 2, vq = tid & 3;
    u32x4 k0 = *(const u32x4*)kg, k1 = *(const u32x4*)(kg + 8), v0 = {0u, 0u, 0u, 0u};
    if (!MAXP) v0 = *(const u32x4*)vg;
    __syncthreads();
    *(LAS u32x4*)(Kb + kkey * KB_PITCH + kseg * 32) = k0; *(LAS u32x4*)(Kb + kkey * KB_PITCH + kseg * 32 + 16) = k1;
    if (!MAXP) { *(LAS u32x2*)(Vb + vd * VB_PITCH + vq * 16) = (u32x2){v0.x, v0.y}; *(LAS u32x2*)(Vb + vd * VB_PITCH + vq * 16 + 8) = (u32x2){v0.z, v0.w}; }
    __syncthreads();
#pragma unroll 1
    for (int mb = 0; mb < 8; ++mb) {
        const int cur = mb & 1, nb = mb + 1 < 8 ? mb + 1 : mb;
        k0 = *(const u32x4*)(kg + (size_t)nb * 32 * 1024); k1 = *(const u32x4*)(kg + (size_t)nb * 32 * 1024 + 8);
        if (!MAXP) v0 = *(const u32x4*)(vg + nb * 32);
        const LAS unsigned char* kb = Kb + cur * KB_BYTES + r32 * KB_PITCH + 16 * hi;
        f32x16 sc;
#pragma unroll
        for (int i = 0; i < 16; ++i) sc[i] = 0.f;
#pragma unroll
        for (int ks = 0; ks < 16; ++ks) { sc = __builtin_amdgcn_mfma_f32_32x32x16_bf16(*(const LAS bf16x8*)(kb + 32 * ks), qf[ks], sc, 0, 0, 0);
            if ((ks & 3) == 3) __builtin_amdgcn_sched_barrier(0); }
        if (MAXP) {
#pragma unroll
            for (int i = 0; i < 16; ++i) mx = fmaxf(mx, sc[i]);
        } else {
#pragma unroll
            for (int i = 0; i < 16; ++i) { sc[i] = __builtin_amdgcn_exp2f(fmaf(sc[i], c2, mneg)); l += sc[i]; }
            const u32x4 w0 = {cvt_pk_bf16(sc[0], sc[1]), cvt_pk_bf16(sc[2], sc[3]), cvt_pk_bf16(sc[4], sc[5]), cvt_pk_bf16(sc[6], sc[7])};
            const u32x4 w1 = {cvt_pk_bf16(sc[8], sc[9]), cvt_pk_bf16(sc[10], sc[11]), cvt_pk_bf16(sc[12], sc[13]), cvt_pk_bf16(sc[14], sc[15])};
            const bf16x8 pa0 = __builtin_bit_cast(bf16x8, w0), pa1 = __builtin_bit_cast(bf16x8, w1);
#pragma unroll
            for (int d0 = 0; d0 < 4; ++d0) { const LAS unsigned char* vp = Vb + cur * VB_BYTES + (d0 * 32 + r32) * VB_PITCH + 8 * hi;
                const u32x2 a0 = *(const LAS u32x2*)vp, a1 = *(const LAS u32x2*)(vp + 16), b0 = *(const LAS u32x2*)(vp + 32), b1 = *(const LAS u32x2*)(vp + 48);
                const u32x4 x0 = {a0.x, a0.y, a1.x, a1.y}, x1 = {b0.x, b0.y, b1.x, b1.y};
                o[d0] = __builtin_amdgcn_mfma_f32_32x32x16_bf16(pa0, __builtin_bit_cast(bf16x8, x0), o[d0], 0, 0, 0);
                o[d0] = __builtin_amdgcn_mfma_f32_32x32x16_bf16(pa1, __builtin_bit_cast(bf16x8, x1), o[d0], 0, 0, 0); } }
        LAS unsigned char* kw = Kb + (cur ^ 1) * KB_BYTES + kkey * KB_PITCH + kseg * 32; *(LAS u32x4*)kw = k0; *(LAS u32x4*)(kw + 16) = k1;
        if (!MAXP) { LAS unsigned char* vw = Vb + (cur ^ 1) * VB_BYTES + vd * VB_PITCH + vq * 16; *(LAS u32x2*)vw = (u32x2){v0.x, v0.y}; *(LAS u32x2*)(vw + 8) = (u32x2){v0.z, v0.w}; }
        __syncthreads();
    }
}
}
__device__ __forceinline__ void ph_mem_attn(const Args& a, LAS unsigned char* lds, int bid, int nblk) {
    unsigned char* ws = a.ws; const int tid = threadIdx.x, lane = tid & 63, wave = __builtin_amdgcn_readfirstlane(tid >> 6), r32 = lane & 31, hi = lane >> 5;
    LAS unsigned char* Kb = lds; LAS unsigned char* Vb = lds + 2 * memat::KB_BYTES; LAS float* linv = (LAS float*)(lds + 2 * memat::KB_BYTES + 2 * memat::VB_BYTES) + wave * 32;
    bf16_t* QDM = (bf16_t*)(ws + WS_QDM); const bf16_t* KM = (const bf16_t*)(ws + WS_KV); const bf16_t* VMT = (const bf16_t*)(ws + WS_KV + MiB);
    for (int grp = bid; grp < (M / 256) * 4; grp += nblk) {
        const int h = grp & 3; const size_t q0 = (size_t)(grp >> 2) * 256 + wave * 32; const int b = (int)(q0 / T);
        bf16x8 qf[16];
#pragma unroll
        for (int ks = 0; ks < 16; ++ks) qf[ks] = *(const bf16x8*)(QDM + (q0 + r32) * 2048 + 1024 + h * 256 + 16 * ks + 8 * hi);
        const bf16_t* kg = KM + ((size_t)b * NMEM + (tid >> 4)) * 1024 + h * 256 + (tid & 15) * 16;
        float mx = -__builtin_inff(), l = 0.f; f32x16 o[4];
        memat::pass<true>(Kb, Vb, kg, nullptr, qf, mx, 0.f, o, l, tid, r32, hi);
        mx = fmaxf(mx, __shfl_xor(mx, 32)); const float mneg = -mx * (0.0625f * 1.4426950408889634f);
#pragma unroll 1
        for (int dh = 0; dh < 2; ++dh) {
            const bf16_t* vg = VMT + ((size_t)b * 1024 + h * 256 + dh * 128 + (tid >> 2)) * 256 + (tid & 3) * 8;
            l = 0.f;
#pragma unroll
            for (int d0 = 0; d0 < 4; ++d0)
#pragma unroll
                for (int i = 0; i < 16; ++i) o[d0][i] = 0.f;
            memat::pass<false>(Kb, Vb, kg, vg, qf, mx, mneg, o, l, tid, r32, hi);
            l += __shfl_xor(l, 32);
            if (hi == 0) linv[r32] = 1.f / l;
            LDS_WAIT(); asm volatile("" ::: "memory");
#pragma unroll
            for (int i = 0; i < 16; ++i) { const int qr = crow(i, hi); const float rl = linv[qr];
#pragma unroll
                for (int d0 = 0; d0 < 4; ++d0) { const float v = o[d0][i] * rl, vn = __shfl_xor(v, 1);
                    if ((r32 & 1) == 0) *(unsigned*)(QDM + (q0 + qr) * 2048 + 1024 + h * 256 + dh * 128 + d0 * 32 + r32) = cvt_pk_bf16(v, vn); } }
            LDS_WAIT(); asm volatile("" ::: "memory");
        }
    }
}

__device__ __forceinline__ void ph_layernorm(float* z, const float* g, const float* bta, unsigned char* xq, int bid, int nblk) {
    const int tid = threadIdx.x, lane = tid & 63, wave = __builtin_amdgcn_readfirstlane(tid >> 6);
    for (int row = bid * 8 + wave; row < M; row += nblk * 8) { float* zr = z + (size_t)row * D;
        f32x4 v[8]; float s = 0.f;
#pragma unroll
        for (int j = 0; j < 8; ++j) { v[j] = *(const f32x4*)(zr + 256 * j + 4 * lane); s += (v[j][0] + v[j][1]) + (v[j][2] + v[j][3]); }
        const float mean = wave_sum(s) * (1.f / D); float s2 = 0.f;
#pragma unroll
        for (int j = 0; j < 8; ++j) { v[j] = v[j] - mean; s2 += (v[j][0] * v[j][0] + v[j][1] * v[j][1]) + (v[j][2] * v[j][2] + v[j][3] * v[j][3]); }
        const float rstd = 1.0f / sqrtf(wave_sum(s2) * (1.f / D) + LN_EPS);
#pragma unroll
        for (int j = 0; j < 8; ++j) { const f32x4 gg = *(const f32x4*)(g + 256 * j + 4 * lane), bb = *(const f32x4*)(bta + 256 * j + 4 * lane); const f32x4 y = v[j] * rstd * gg + bb;
            *(f32x4*)(zr + 256 * j + 4 * lane) = y;
            if (xq) *(unsigned*)(xq + (size_t)row * D + 256 * j + 4 * lane) = pk_fp8x4(y[0], y[1], y[2], y[3]); } }
}

constexpr int NPHASE = 11;
__global__ void __launch_bounds__(512, 2) fwd(Args args) {
    extern __shared__ __attribute__((aligned(16))) unsigned char lds_raw[];
    LAS unsigned char* lds = (LAS unsigned char*)lds_raw;
    unsigned char* ws = args.ws; const int bid = blockIdx.x, nblk = gridDim.x;
    const int lo = args.ph_lo, hi = args.ph_hi;
    volatile LAS unsigned* xbw = (volatile LAS unsigned*)(lds + LDS_BYTES - 16);
    if (threadIdx.x == 0) { xbw[0] = 0u; xbw[1] = 0u; xbw[2] = 0u; xbw[3] = 0u; }
    __syncthreads();
    XcdBarrier bar = xcd_barrier_post((unsigned*)(ws + WS_CTL) + 4096, xbw);
#define GRID_BAR() xcd_barrier(bar)
#define IN(k) (lo <= (k) && (k) < hi)
#define SEAM(k) do { if (IN(k) && IN((k) + 1)) GRID_BAR(); } while (0)
    bf16_t* XB = (bf16_t*)(ws + WS_XB);
    if (IN(0)) { ph_prologue(args, lds, bid, nblk); SEAM(0); }
    if (IN(1)) {
        { pg8::InProjSched S{ws + WS_XQ, ws + WS_W1, 2048, 4096, 16, M / 256, 40, nblk, bid, true}; EpiInProj E{ws, (unsigned char*)args.out, 1.0f / W1_SCALE}; pg8::gemm_phase<true>(lds, S, E); }
        { pg8::InProjSched S{XB, ws + WS_W1, 4096, 4096, 32, M / 256, 5, nblk, bid, false}; EpiInProj E{ws, (unsigned char*)args.out, 1.0f}; pg8::gemm_phase(lds, S, E); }
        { pg8::PlainSched S{ws + WS_MEMB, ws + WS_WMKV, 4096, 4096, 32, 2, 8, nblk, bid}; EpiKV E{(bf16_t*)(ws + WS_KV), (bf16_t*)(ws + WS_KV + MiB)}; pg8::gemm_phase(lds, S, E); }
        SEAM(1);
    }
    if (IN(2)) { ph_dsa_norms(args, lds, bid, nblk); ph_gla_prep(args, lds, bid, nblk); __syncthreads(); ph_dsa_index(args, lds, bid, nblk); __syncthreads();
 ph_mem_attn(args, lds, bid, nblk); SEAM(2); }
    if (IN(3)) { ph_gla_scan(args, lds, bid, nblk); __syncthreads(); ph_dsa_attn(args, (char*)lds_raw, bid, nblk);
        SEAM(3); }
    if (IN(4)) { ph_gla_final(args, bid, nblk);
        { pg8::PlainSched S{ws + WS_XQ, ws + WS_WG, 2048, 2048, 16, M / 256, 24, nblk, bid}; EpiGate E{(bf16_t*)(ws + WS_G), args.in[I_BMERGE]}; pg8::gemm_phase<true>(lds, S, E); }
        SEAM(4); }
    if (IN(5)) { { pg8::MergeSched S{(const unsigned char*)args.out + DO_OGQ, (const unsigned char*)args.out + DO_ODMQ, ws + WS_BRG, ws + WS_BRDM, 2048, 2048, M / 256, 8, nblk, bid};
        EpiMerge E{XB, (const bf16_t*)(ws + WS_G), ws + WS_XQ}; pg8::gemm_phase<true>(lds, S, E); } SEAM(5); }
    if (IN(6)) { { pg8::PlainSched S{ws + WS_XQ, ws + WS_WO, 2048, 2048, 16, M / 256, 8, nblk, bid}; EpiResid E{args.in[I_X], args.out, nullptr, 1.0f / WO_SCALE}; pg8::gemm_phase<true>(lds, S, E); } SEAM(6); }
    if (IN(7)) { ph_layernorm(args.out, args.in[I_LN1G], args.in[I_LN1B], ws + WS_GR, bid, nblk); SEAM(7); }
    if (IN(8)) { { pg8::PlainSched S{ws + WS_GR, ws + WS_WUP, 2048, 2048, 16, M / 256, 32, nblk, bid}; EpiRelu2 E{ws + WS_U, args.in[I_BUP]}; pg8::gemm_phase<true>(lds, S, E); } SEAM(8); }
    if (IN(9)) { pg8::PlainSched S{ws + WS_U, ws + WS_WDOWN, 8192, 8192, 64, M / 256, 8, nblk, bid}; EpiResid E{args.out, args.out, args.in[I_BDOWN], 1.0f / WD_SCALE}; pg8::gemm_phase<true>(lds, S, E); SEAM(9); }
    if (IN(10)) { ph_layernorm(args.out, args.in[I_LN2G], args.in[I_LN2B], nullptr, bid, nblk); }
#undef IN
#undef SEAM
}

extern "C" void kernel_launch(void* const* d_in, const int* in_sizes, int n_in, void* d_out, int out_size, void* d_ws, size_t ws_size, hipStream_t stream) {
    static int grid = 0;
    if (grid == 0) {
        if (n_in != 20 || out_size != M * D || ws_size < WS_END) { fprintf(stderr, "kernel_launch: unexpected shapes (n_in %d, out %d, ws %zu)\n", n_in, out_size, ws_size); grid = -1; return; }
        int dev = 0, cus = 0;
        if (hipGetDevice(&dev) != hipSuccess || hipDeviceGetAttribute(&cus, hipDeviceAttributeMultiprocessorCount, dev) != hipSuccess) { grid = -1; return; }
        if (hipFuncSetAttribute((const void*)fwd, hipFuncAttributeMaxDynamicSharedMemorySize, LDS_BYTES) != hipSuccess) { grid = -1; return; }
        int per_cu = 0;
        if (hipOccupancyMaxActiveBlocksPerMultiprocessor(&per_cu, (const void*)fwd, 512, LDS_BYTES) != hipSuccess || per_cu < 1) { fprintf(stderr, "kernel_launch: occupancy query says %d\n", per_cu); }
        (void)hipGetLastError();
        grid = cus;
    }
    if (grid < 0) return;
    (void)hipMemsetAsync((char*)d_ws + WS_CTL, 0, CTL_ZERO_BYTES, stream);
    Args a{};
    for (int i = 0; i < 20; ++i) a.in[i] = (const float*)d_in[i];
    a.out = (float*)d_out; a.ws = (unsigned char*)d_ws;
    a.ph_lo = 0; a.ph_hi = NPHASE;
    hipLaunchKernelGGL(fwd, dim3(grid), dim3(512), LDS_BYTES, stream, a);
}
```

```cpp
#include <hip/hip_runtime.h>
#include <cstdio>
#include <cstdint>

#define LAS __attribute__((address_space(3)))
#define GAS __attribute__((address_space(1)))
typedef unsigned short bf16_t;
typedef short bf16x8 __attribute__((ext_vector_type(8)));
typedef float f32x4 __attribute__((ext_vector_type(4)));
typedef float f32x16 __attribute__((ext_vector_type(16)));
typedef unsigned u32x4 __attribute__((ext_vector_type(4)));
typedef unsigned u32x2 __attribute__((ext_vector_type(2)));

constexpr int BATCH = 2, T = 16384, D = 2048, M = BATCH * T, FF = 8192, NMEM = 256;
constexpr int NCHUNK = T / 64;
constexpr int IN_W = 17504;
constexpr float ALPHA = 1.189207115002721f;
constexpr float LN_EPS = 1e-5f, RMS_EPS = 1e-6f;
constexpr float WG_SCALE = 64.f, WD_SCALE = 256.f, WU_SCALE = 64.f, W1_SCALE = 64.f, WB_SCALE = 64.f, WO_SCALE = 64.f, OMEM_SCALE = 16.f;

constexpr size_t MiB = 1u << 20;
constexpr size_t WS_CTL = 0, CTL_ZERO_BYTES = 1 * MiB;
constexpr int CW_QHEAD = 8192, CW_DNB = 8256, CW_NRM = 8448;
constexpr size_t WS_BRG = 2 * MiB, WS_BRDM = 10 * MiB, WS_WO = 18 * MiB, WS_WUP = 26 * MiB, WS_WDOWN = 58 * MiB, WS_WMKV = 90 * MiB, WS_WG = 98 * MiB, WS_W1 = 122 * MiB;
constexpr size_t WS_MEMB = 167 * MiB, WS_KV = 169 * MiB, WS_DEC = 171 * MiB;
constexpr size_t WS_XB = 176 * MiB;
constexpr size_t WS_GR = 304 * MiB;
constexpr size_t WS_QDM = 432 * MiB;
constexpr size_t WS_DK = 560 * MiB, WS_DV = 624 * MiB, WS_IQ = 688 * MiB;
constexpr size_t WS_SMF = 752 * MiB;
constexpr size_t WS_SMB = 784 * MiB;
constexpr size_t WS_KT = 800 * MiB;
constexpr size_t WS_AM = 864 * MiB;
constexpr size_t WS_SEL = 880 * MiB;
constexpr size_t WS_G = 560 * MiB;
constexpr size_t WS_U = 432 * MiB;
constexpr size_t WS_IKB = 944 * MiB;
constexpr size_t WS_XQ = 948 * MiB;
constexpr size_t WS_END = 1012 * MiB;
constexpr size_t DO_GQ = 0, DO_GK = 64 * MiB, DO_GV = 128 * MiB;
constexpr size_t DO_OGQ = 0, DO_ODMQ = 64 * MiB;

constexpr int LDS_BYTES = 163840;

__device__ __forceinline__ unsigned f2bf(float f) { unsigned u = __builtin_bit_cast(unsigned, f); return (u + 0x7fffu + ((u >> 16) & 1u)) >> 16; }
__device__ __forceinline__ unsigned pk2(float lo, float hi) { return f2bf(lo) | (f2bf(hi) << 16); }
typedef float f32x2_t __attribute__((ext_vector_type(2)));
typedef __bf16 bf16x2_t __attribute__((ext_vector_type(2)));
__device__ __forceinline__ unsigned cvt_pk_bf16(float lo, float hi) { f32x2_t v = {lo, hi}; bf16x2_t b = __builtin_convertvector(v, bf16x2_t); return __builtin_bit_cast(unsigned, b); }
__device__ __forceinline__ unsigned pk_fp8x4(float a, float b, float c, float d) { int w = 0; w = __builtin_amdgcn_cvt_pk_fp8_f32(a, b, w, false); w = __builtin_amdgcn_cvt_pk_fp8_f32(c, d, w, true); return (unsigned)w; }
__device__ __forceinline__ float bf2f(unsigned b) { return __builtin_bit_cast(float, b << 16); }
__device__ __forceinline__ float bflo(unsigned w) { return __builtin_bit_cast(float, w << 16); }
__device__ __forceinline__ float bfhi(unsigned w) { return __builtin_bit_cast(float, w & 0xffff0000u); }
__device__ __forceinline__ float wave_sum(float v) {
#pragma unroll
    for (int o = 1; o < 64; o <<= 1) v += __shfl_xor(v, o);
    return v;
}
__device__ __forceinline__ float wave_max(float v) {
#pragma unroll
    for (int o = 1; o < 64; o <<= 1) v = fmaxf(v, __shfl_xor(v, o));
    return v;
}
#define LDS_WAIT() asm volatile("s_waitcnt lgkmcnt(0)" ::: "memory")
#define WG_BAR_LDS() do { asm volatile("s_waitcnt lgkmcnt(0)" ::: "memory"); __builtin_amdgcn_s_barrier(); asm volatile("" ::: "memory"); } while (0)
#define VM_WAIT() asm volatile("s_waitcnt vmcnt(0)" ::: "memory")

struct Args { const float* in[20]; float* out; unsigned char* ws; int ph_lo, ph_hi; };
enum { I_X = 0, I_MEM, I_WIN, I_WGU, I_BG, I_NG, I_WMKV, I_WBG, I_WBD, I_WBM, I_BMERGE, I_WO, I_LN1G, I_LN1B, I_WUP, I_BUP, I_WDOWN, I_BDOWN, I_LN2G, I_LN2B };

namespace pg8 {
constexpr int BM = 256, BK = 64, HALF = 128, HTB = HALF * BK * 2, STAGE_BYTES = 8 * HTB, NXCD = 8, WGM = 8;
__host__ __device__ __forceinline__ int lds_byte(int r, int c) { const int st = (r >> 4) * 2 + (c >> 5), rr = r & 15, cc = c & 31, ob = rr * 64 + cc * 2; return st * 1024 + (ob ^ (((ob >> 9) & 1) << 5)); }
__host__ __device__ __forceinline__ void stage_rc(int b, int& R, int& C) { const int st = b / 1024, sb = b % 1024, swz = sb ^ (((sb >> 9) & 1) << 5); R = (st >> 1) * 16 + swz / 64; C = (st & 1) * 32 + (swz % 64) / 2; }
__host__ __device__ __forceinline__ int perm32(int rho) { const int n = rho >> 4, i = rho & 15; return 8 * (i >> 2) + 4 * n + (i & 3); }

struct Unit { int pm, pn, sub; };
__device__ __forceinline__ bool tile_of(long L, int nM, int nN, Unit& u) {
    const int nwg = nM * nN; if (L >= nwg) return false;
    int wgid = (int)L; { const int q = nwg / NXCD, r = nwg % NXCD, xcd = wgid % NXCD, off = wgid / NXCD; wgid = (xcd < r ? xcd * (q + 1) : r * (q + 1) + (xcd - r) * q) + off; }
    const int nig = WGM * nN, gid = wgid / nig, fm = gid * WGM, gsz = (nM - fm) < WGM ? (nM - fm) : WGM;
    u.pm = fm + ((wgid % nig) % gsz); u.pn = (wgid % nig) / gsz; u.sub = 0; return true;
}
struct PlainSched {
    const void* A; const void* Bt; int lda, ldb, KT, nM, nN, G, c;
    __device__ __forceinline__ bool next(int i, Unit& u) const { return tile_of((long)i * G + c, nM, nN, u); }
    __device__ __forceinline__ const char* aptr(const Unit& u) const { return (const char*)A + (size_t)u.pm * BM * lda; }
    __device__ __forceinline__ const char* bptr(const Unit& u) const { return (const char*)Bt + (size_t)u.pn * BM * ldb; }
    __device__ __forceinline__ int nt(const Unit&) const { return KT; }
};
struct InProjSched {
    const void* A; const void* Bt; int lda, ldb, KT, nM, nN, G, c; bool lowp;
    __device__ __forceinline__ bool next(int i, Unit& u) const { if (!tile_of((long)i * G + c, nM, nN, u)) return false; u.pn = lowp ? (u.pn < 36 ? u.pn : u.pn + 4) : (u.pn < 4 ? 36 + u.pn : 44); return true; }
    __device__ __forceinline__ const char* aptr(const Unit& u) const { return (const char*)A + (size_t)u.pm * BM * lda; }
    __device__ __forceinline__ const char* bptr(const Unit& u) const { return (const char*)Bt + (size_t)u.pn * BM * ldb; }
    __device__ __forceinline__ int nt(const Unit&) const { return KT; }
};
struct MergeSched {
    const unsigned char* OG; const unsigned char* ODM; const unsigned char* WG; const unsigned char* WDM; int lda, ldb, nM, nN, G, c;
    __device__ __forceinline__ bool next(int i, Unit& u) const { const int ti = i / 3, sub = i - 3 * ti; if (!tile_of((long)ti * G + c, nM, nN, u)) return false; u.sub = sub; return true; }
    __device__ __forceinline__ const char* aptr(const Unit& u) const { const unsigned char* p = u.sub == 0 ? OG : (u.sub == 1 ? ODM : ODM + 1024); return (const char*)(p + (size_t)u.pm * BM * 2048); }
    __device__ __forceinline__ const char* bptr(const Unit& u) const { const unsigned char* p = u.sub == 0 ? WG : (u.sub == 1 ? WDM : WDM + 1024); return (const char*)(p + (size_t)u.pn * BM * 2048); }
    __device__ __forceinline__ int nt(const Unit& u) const { return u.sub == 0 ? 16 : 8; }
};

typedef int v8i __attribute__((ext_vector_type(8)));
typedef int v4i __attribute__((ext_vector_type(4)));
template <bool FP8 = false, class Epi, class Sched>
__device__ __forceinline__ void gemm_phase(LAS unsigned char* lds, const Sched& S, const Epi& E) {
    const int tid = threadIdx.x, wid = __builtin_amdgcn_readfirstlane(tid >> 6), lane = tid & 63, wr = wid >> 2, wc = wid & 3, fr = lane & 15, fq = lane >> 4;
    const int lda = S.lda, ldb = S.ldb;
    unsigned voffA[2], voffB[2];
#pragma unroll
    for (int i = 0; i < 2; ++i) { int R, C; stage_rc(tid * 16 + i * 8192, R, C); const int Rb = (R & ~31) + perm32(R & 31);
        voffA[i] = (unsigned)(R * lda + C * 2); voffB[i] = (unsigned)(Rb * ldb + C * 2); }
    const size_t kstep = (size_t)(BK * 2);
    const size_t hstepA = (size_t)HALF * lda, hstepB = (size_t)HALF * ldb;
    const unsigned ldsw = (unsigned)wid * 1024u;
    const int aoff = lds_byte(wr * 64 + fr, fq * 8), boff = lds_byte(wc * 32 + fr, fq * 8);
#define PG8_SA(b, h) (((b) * 2 + (h)) * HTB)
#define PG8_SB(b, h) ((4 + (b) * 2 + (h)) * HTB)
#define PG8_STAGE(bufoff, gbase, voff) do { _Pragma("unroll") for (int _i = 0; _i < 2; ++_i) \
        __builtin_amdgcn_global_load_lds((const unsigned*)((const char*)(gbase) + (voff)[_i]), (LAS unsigned*)(lds + (bufoff) + ldsw + _i * 8192), 16, 0, 0); } while (0)
#define PG8_CAT(x0, x1) __builtin_shufflevector(x0, x1, 0, 1, 2, 3, 4, 5, 6, 7)
#define PG8_LDA(dst, b, h) do { _Pragma("unroll") for (int m = 0; m < 4; ++m) { if constexpr (FP8) dst##8[m] = PG8_CAT(*(const LAS v4i*)(lds + PG8_SA(b, h) + aoff + m * 2048), *(const LAS v4i*)(lds + PG8_SA(b, h) + aoff + m * 2048 + 1024)); \
        else { _Pragma("unroll") for (int k = 0; k < 2; ++k) dst[m][k] = *(const LAS bf16x8*)(lds + PG8_SA(b, h) + aoff + m * 2048 + k * 1024); } } } while (0)
#define PG8_LDB(dst, b, h) do { _Pragma("unroll") for (int n = 0; n < 2; ++n) { if constexpr (FP8) dst##8[n] = PG8_CAT(*(const LAS v4i*)(lds + PG8_SB(b, h) + boff + n * 2048), *(const LAS v4i*)(lds + PG8_SB(b, h) + boff + n * 2048 + 1024)); \
        else { _Pragma("unroll") for (int k = 0; k < 2; ++k) dst[n][k] = *(const LAS bf16x8*)(lds + PG8_SB(b, h) + boff + n * 2048 + k * 1024); } } } while (0)
#define PG8_MMA(ai, bj, At, Bt) do { __builtin_amdgcn_s_setprio(1); _Pragma("unroll") for (int m = 0; m < 4; ++m) _Pragma("unroll") for (int n = 0; n < 2; ++n) { \
        if constexpr (FP8) asm volatile("v_mfma_f32_16x16x128_f8f6f4 %0, %1, %2, %0" : "+v"(acc[ai][bj][m][n]) : "v"(Bt##8[n]), "v"(At##8[m]));     \
        else { _Pragma("unroll") for (int k = 0; k < 2; ++k) acc[ai][bj][m][n] = __builtin_amdgcn_mfma_f32_16x16x32_bf16(Bt[n][k], At[m][k], acc[ai][bj][m][n], 0, 0, 0); } } \
        __builtin_amdgcn_s_setprio(0); } while (0)
#define PG8_WAIT_V(n) asm volatile("s_waitcnt vmcnt(" #n ")" ::: "memory")
#define PG8_WAIT_L(n) asm volatile("s_waitcnt lgkmcnt(" #n ")" ::: "memory")
#define PG8_BAR __builtin_amdgcn_s_barrier()
#define PG8_SCHED __builtin_amdgcn_sched_barrier(0)
    Unit cur, nxt; int ui = 0;
    if (!S.next(0, cur)) return;
    f32x4 acc[2][2][4][2];
#pragma unroll
    for (int a = 0; a < 2; ++a)
#pragma unroll
        for (int b = 0; b < 2; ++b)
#pragma unroll
            for (int m = 0; m < 4; ++m)
#pragma unroll
                for (int n = 0; n < 2; ++n) acc[a][b][m][n] = (f32x4){0.f, 0.f, 0.f, 0.f};
    bf16x8 At[4][2], B0[2][2], B1[2][2]; v8i At8[4], B08[2], B18[2]; (void)At; (void)B0; (void)B1; (void)At8; (void)B08; (void)B18;
    const char* cA = S.aptr(cur); const char* cB = S.bptr(cur); int nt = S.nt(cur);
    PG8_STAGE(PG8_SB(0, 0), cB, voffB); PG8_STAGE(PG8_SB(0, 1), cB + hstepB, voffB); PG8_STAGE(PG8_SA(0, 0), cA, voffA); PG8_STAGE(PG8_SA(0, 1), cA + hstepA, voffA);
    if (wr == 1) PG8_BAR;
    PG8_WAIT_V(2); PG8_BAR;
    PG8_STAGE(PG8_SB(1, 0), cB + kstep, voffB); PG8_STAGE(PG8_SA(1, 0), cA + kstep, voffA); PG8_STAGE(PG8_SB(1, 1), cB + hstepB + kstep, voffB);
    PG8_WAIT_V(6); PG8_BAR;
    for (;;) {
        const bool has_next = S.next(ui + 1, nxt);
        const char* nA = has_next ? S.aptr(nxt) : cA; const char* nB = has_next ? S.bptr(nxt) : cB;
        for (int t = 0; t < nt; t += 2) {
            const bool last = (t == nt - 2);
            const char* a1 = cA + (size_t)(t + 1) * kstep;
            const char* a2 = last ? nA : cA + (size_t)(t + 2) * kstep; const char* b2 = last ? nB : cB + (size_t)(t + 2) * kstep;
            const char* a3 = a2 + kstep; const char* b3 = b2 + kstep;
            PG8_LDB(B0, 0, 0); PG8_LDB(B1, 0, 1); PG8_SCHED; PG8_LDA(At, 0, 0); PG8_STAGE(PG8_SA(1, 1), a1 + hstepA, voffA);
            PG8_WAIT_V(8); PG8_WAIT_L(0); PG8_BAR; PG8_MMA(0, 0, At, B0); PG8_MMA(0, 1, At, B1); PG8_BAR; PG8_SCHED;
            PG8_LDA(At, 0, 1); PG8_STAGE(PG8_SB(0, 0), b2, voffB); PG8_STAGE(PG8_SB(0, 1), b2 + hstepB, voffB); PG8_STAGE(PG8_SA(0, 0), a2, voffA);
            PG8_WAIT_V(8); PG8_WAIT_L(0); PG8_BAR; PG8_MMA(1, 0, At, B0); PG8_MMA(1, 1, At, B1); PG8_BAR; PG8_SCHED;
            PG8_LDB(B0, 1, 0); PG8_LDB(B1, 1, 1); PG8_SCHED; PG8_LDA(At, 1, 0); PG8_STAGE(PG8_SA(0, 1), a2 + hstepA, voffA);
            PG8_WAIT_V(8); PG8_WAIT_L(0); PG8_BAR; PG8_MMA(0, 0, At, B0); PG8_MMA(0, 1, At, B1); PG8_BAR; PG8_SCHED;
            PG8_LDA(At, 1, 1); PG8_STAGE(PG8_SB(1, 0), b3, voffB); PG8_STAGE(PG8_SB(1, 1), b3 + hstepB, voffB); PG8_STAGE(PG8_SA(1, 0), a3, voffA);
            PG8_WAIT_V(8); PG8_WAIT_L(0); PG8_BAR; PG8_MMA(1, 0, At, B0); PG8_MMA(1, 1, At, B1); PG8_BAR; PG8_SCHED;
        }
        if (wr == 0) PG8_BAR;
        if constexpr (FP8) asm volatile("s_nop 7\n\ts_nop 7\n\ts_nop 7" ::: "memory");
        E(acc, cur, wr, wc, fr, fq);
        if (!has_next) break;
#pragma unroll
        for (int a = 0; a < 2; ++a)
#pragma unroll
            for (int b = 0; b < 2; ++b)
#pragma unroll
                for (int m = 0; m < 4; ++m)
#pragma unroll
                    for (int n = 0; n < 2; ++n) acc[a][b][m][n] = (f32x4){0.f, 0.f, 0.f, 0.f};
        cur = nxt; cA = nA; cB = nB; nt = S.nt(cur); ++ui;
        if (wr == 1) PG8_BAR;
    }
    PG8_WAIT_V(0);
    PG8_BAR;
#undef PG8_SA
#undef PG8_SB
#undef PG8_STAGE
#undef PG8_LDA
#undef PG8_LDB
#undef PG8_MMA
#undef PG8_CAT
#undef PG8_WAIT_V
#undef PG8_WAIT_L
#undef PG8_BAR
#undef PG8_SCHED
}
}
using pg8::Unit;
typedef f32x4 AccT[2][2][4][2];

__device__ __forceinline__ u32x4 pack8(f32x4 v0, f32x4 v1) { u32x4 w; w.x = cvt_pk_bf16(v0[0], v0[1]); w.y = cvt_pk_bf16(v0[2], v0[3]); w.z = cvt_pk_bf16(v1[0], v1[1]); w.w = cvt_pk_bf16(v1[2], v1[3]); return w; }
__device__ __forceinline__ void unpack8(u32x4 w, f32x4& v0, f32x4& v1) { v0 = (f32x4){bflo(w.x), bfhi(w.x), bflo(w.y), bfhi(w.y)}; v1 = (f32x4){bflo(w.z), bfhi(w.z), bflo(w.w), bfhi(w.w)}; }

struct EpiInProj {
    unsigned char* ws; unsigned char* dout; float ascale;
    __device__ __forceinline__ void operator()(const AccT& acc, const Unit& u, int wr, int wc, int fr, int fq) const {
        const int pn = u.pn; bf16_t* base; int ldc, c0;
        if (pn < 4) { base = (bf16_t*)(dout + DO_GQ); ldc = 1024; c0 = pn * 256; }
        else if (pn < 8) { base = (bf16_t*)(dout + DO_GK); ldc = 1024; c0 = (pn - 4) * 256; }
        else if (pn < 16) { base = (bf16_t*)(dout + DO_GV); ldc = 2048; c0 = (pn - 8) * 256; }
        else if (pn < 24) { base = (bf16_t*)(ws + WS_GR); ldc = 2048; c0 = (pn - 16) * 256; }
        else if (pn < 28) { base = (bf16_t*)(ws + WS_QDM); ldc = 2048; c0 = (pn - 24) * 256; }
        else if (pn < 32) { base = (bf16_t*)(ws + WS_DK); ldc = 1024; c0 = (pn - 28) * 256; }
        else if (pn < 36) { base = (bf16_t*)(ws + WS_DV); ldc = 1024; c0 = (pn - 32) * 256; }
        else if (pn < 40) { base = (bf16_t*)(ws + WS_IQ); ldc = 1024; c0 = (pn - 36) * 256; }
        else if (pn < 44) { base = (bf16_t*)(ws + WS_QDM); ldc = 2048; c0 = 1024 + (pn - 40) * 256; }
        else { base = (bf16_t*)(ws + WS_SMB); ldc = 256; c0 = 0; }
        float* fbase = (float*)(ws + WS_SMF);
#pragma unroll
        for (int ai = 0; ai < 2; ++ai)
#pragma unroll
            for (int m = 0; m < 4; ++m) { const size_t row = (size_t)u.pm * 256 + ai * 128 + wr * 64 + m * 16 + fr;
#pragma unroll
                for (int bj = 0; bj < 2; ++bj) { const int cl = bj * 128 + wc * 32 + 8 * fq;
                    *(u32x4*)(base + row * ldc + c0 + cl) = pack8(acc[ai][bj][m][0] * ascale, acc[ai][bj][m][1] * ascale);
                    if (pn == 44) { *(f32x4*)(fbase + row * 256 + cl) = acc[ai][bj][m][0]; *(f32x4*)(fbase + row * 256 + cl + 4) = acc[ai][bj][m][1];
                        if (cl < 64) *(u32x4*)((bf16_t*)(ws + WS_IKB) + ((((row >> 5) * 4 + (cl >> 4)) * 64 + ((cl >> 3) & 1) * 32 + (row & 31)) << 3)) = pack8(acc[ai][bj][m][0], acc[ai][bj][m][1]); } } }
    }
};
struct EpiKV {
    bf16_t* KM; bf16_t* VMT;
    __device__ __forceinline__ void operator()(const AccT& acc, const Unit& u, int wr, int wc, int fr, int fq) const {
#pragma unroll
        for (int ai = 0; ai < 2; ++ai)
#pragma unroll
            for (int m = 0; m < 4; ++m) { const int row = u.pm * 256 + ai * 128 + wr * 64 + m * 16 + fr;
#pragma unroll
                for (int bj = 0; bj < 2; ++bj) { const int col = u.pn * 256 + bj * 128 + wc * 32 + 8 * fq;
                    if (u.pn < 4) *(u32x4*)(KM + (size_t)row * 1024 + col) = pack8(acc[ai][bj][m][0], acc[ai][bj][m][1]);
                    else { bf16_t* vp = VMT + ((size_t)(row >> 8) * 1024 + (col - 1024)) * 256 + (row & 255);
#pragma unroll
                        for (int j = 0; j < 4; ++j) { vp[(size_t)j * 256] = (bf16_t)f2bf(acc[ai][bj][m][0][j]); vp[(size_t)(j + 4) * 256] = (bf16_t)f2bf(acc[ai][bj][m][1][j]); } } } }
    }
};
struct EpiGate {
    bf16_t* O; const float* bias;
    __device__ __forceinline__ void operator()(const AccT& acc, const Unit& u, int wr, int wc, int fr, int fq) const {
#pragma unroll
        for (int bj = 0; bj < 2; ++bj) { const int col = u.pn * 256 + bj * 128 + wc * 32 + 8 * fq;
            const f32x4 b0 = *(const f32x4*)(bias + col), b1 = *(const f32x4*)(bias + col + 4);
#pragma unroll
            for (int ai = 0; ai < 2; ++ai)
#pragma unroll
                for (int m = 0; m < 4; ++m) { const size_t row = (size_t)u.pm * 256 + ai * 128 + wr * 64 + m * 16 + fr;
                    f32x4 v0 = acc[ai][bj][m][0] * (1.0f / WG_SCALE) + b0, v1 = acc[ai][bj][m][1] * (1.0f / WG_SCALE) + b1;
#pragma unroll
                    for (int j = 0; j < 4; ++j) { v0[j] = 1.f / (1.f + __expf(-v0[j])); v1[j] = 1.f / (1.f + __expf(-v1[j])); }
                    *(u32x4*)(O + row * 6144 + col) = pack8(v0, v1); } }
    }
};
struct EpiMerge {
    bf16_t* MG; const bf16_t* G; unsigned char* MQ;
    __device__ __forceinline__ void operator()(const AccT& acc, const Unit& u, int wr, int wc, int fr, int fq) const {
        const float sc = u.sub == 2 ? 1.0f / (WB_SCALE * OMEM_SCALE) : 1.0f / WB_SCALE;
#pragma unroll
        for (int ai = 0; ai < 2; ++ai)
#pragma unroll
            for (int m = 0; m < 4; ++m) { const size_t row = (size_t)u.pm * 256 + ai * 128 + wr * 64 + m * 16 + fr;
#pragma unroll
                for (int bj = 0; bj < 2; ++bj) { const int col = u.pn * 256 + bj * 128 + wc * 32 + 8 * fq;
                    f32x4 g0, g1; unpack8(*(const u32x4*)(G + row * 6144 + u.sub * 2048 + col), g0, g1);
                    f32x4 v0 = acc[ai][bj][m][0] * sc * g0, v1 = acc[ai][bj][m][1] * sc * g1;
                    if (u.sub != 0) { f32x4 o0, o1; unpack8(*(const u32x4*)(MG + row * 2048 + col), o0, o1); v0 += o0; v1 += o1; }
                    if (u.sub != 2) *(u32x4*)(MG + row * 2048 + col) = pack8(v0, v1);
                    else *(u32x2*)(MQ + row * 2048 + col) = (u32x2){pk_fp8x4(v0[0], v0[1], v0[2], v0[3]), pk_fp8x4(v1[0], v1[1], v1[2], v1[3])}; } }
        asm volatile("" ::: "memory");
    }
};
struct EpiResid {
    const float* base; float* out; const float* bias; float ascale;
    __device__ __forceinline__ void operator()(const AccT& acc, const Unit& u, int wr, int wc, int fr, int fq) const {
#pragma unroll
        for (int bj = 0; bj < 2; ++bj) { const int col = u.pn * 256 + bj * 128 + wc * 32 + 8 * fq;
            f32x4 b0 = (f32x4){0.f, 0.f, 0.f, 0.f}, b1 = b0; if (bias) { b0 = *(const f32x4*)(bias + col); b1 = *(const f32x4*)(bias + col + 4); }
#pragma unroll
            for (int ai = 0; ai < 2; ++ai)
#pragma unroll
                for (int m = 0; m < 4; ++m) { const size_t off = ((size_t)u.pm * 256 + ai * 128 + wr * 64 + m * 16 + fr) * 2048 + col;
                    const f32x4 x0 = *(const f32x4*)(base + off), x1 = *(const f32x4*)(base + off + 4);
                    *(f32x4*)(out + off) = x0 * ALPHA + acc[ai][bj][m][0] * ascale + b0; *(f32x4*)(out + off + 4) = x1 * ALPHA + acc[ai][bj][m][1] * ascale + b1; } }
    }
};
struct EpiRelu2 {
    unsigned char* O; const float* bias;
    __device__ __forceinline__ void operator()(const AccT& acc, const Unit& u, int wr, int wc, int fr, int fq) const {
#pragma unroll
        for (int bj = 0; bj < 2; ++bj) { const int col = u.pn * 256 + bj * 128 + wc * 32 + 8 * fq;
            const f32x4 b0 = *(const f32x4*)(bias + col), b1 = *(const f32x4*)(bias + col + 4);
#pragma unroll
            for (int ai = 0; ai < 2; ++ai)
#pragma unroll
                for (int m = 0; m < 4; ++m) { const size_t row = (size_t)u.pm * 256 + ai * 128 + wr * 64 + m * 16 + fr;
                    f32x4 v0 = acc[ai][bj][m][0] * (1.0f / WU_SCALE) + b0, v1 = acc[ai][bj][m][1] * (1.0f / WU_SCALE) + b1;
#pragma unroll
                    for (int j = 0; j < 4; ++j) { const float a = fmaxf(v0[j], 0.f), b = fmaxf(v1[j], 0.f); v0[j] = a * a; v1[j] = b * b; }
                    *(u32x2*)(O + row * 8192 + col) = (u32x2){pk_fp8x4(v0[0], v0[1], v0[2], v0[3]), pk_fp8x4(v1[0], v1[1], v1[2], v1[3])}; } }
    }
};

#define XB_TMO      128
#define XB_XCNT(j)  (256  + 64 * (j))
#define XB_XSUB(j)  (1280 + 64 * (j))
#define XB_XGEN(j)  (2304 + 64 * (j))
#define XB_TOP      3328
#define XB_TOPGEN   3392
#define XCD_BAR_WORDS 3456
#define XB_SPIN_CAP (1u << 18)
__device__ __forceinline__ unsigned xb_ld(unsigned* p)              { return __hip_atomic_load(p, __ATOMIC_RELAXED, __HIP_MEMORY_SCOPE_AGENT); }
__device__ __forceinline__ unsigned xb_add(unsigned* p, unsigned v) { return __hip_atomic_fetch_add(p, v, __ATOMIC_RELAXED, __HIP_MEMORY_SCOPE_AGENT); }
__device__ __forceinline__ unsigned xb_xcc_id() { return (unsigned)__builtin_amdgcn_s_getreg((3 << 11) | 20) & 0xFu; }
#define XB_SPIN(cond, bar) do { unsigned _sp = 0; while (cond) { __builtin_amdgcn_s_sleep(1); \
    if ((++_sp & 255u) == 0u) { if (xb_ld(&(bar)[XB_TMO])) break; if (_sp > XB_SPIN_CAP) { atomicAdd(&(bar)[XB_TMO], 1u); break; } } } } while (0)
struct XcdBarrier { unsigned* bar; unsigned x; volatile LAS unsigned* st; };
__device__ __forceinline__ XcdBarrier xcd_barrier_post(unsigned* bar, volatile LAS unsigned* st) {
    XcdBarrier b; b.bar = bar; b.x = xb_xcc_id(); b.st = st;
    if (threadIdx.x == 0) (void)xb_add(&bar[XB_XCNT(b.x)], 1u);
    return b;
}
__device__ __forceinline__ void xcd_barrier_complete(unsigned* bar, unsigned x, unsigned& nloc, unsigned& nx) {
    const unsigned G = gridDim.x * gridDim.y * gridDim.z;
    unsigned sum, cnt, mine, sp = 0u;
    for (;;) {
        sum = 0u; cnt = 0u; mine = 0u;
#pragma unroll
        for (unsigned j = 0; j < 16; ++j) { const unsigned c = xb_ld(&bar[XB_XCNT(j)]); sum += c; cnt += (c > 0u) ? 1u : 0u; mine = (j == x) ? c : mine; }
        if (sum == G) break;
        __builtin_amdgcn_s_sleep(1);
        if ((++sp & 255u) == 0u) { if (xb_ld(&bar[XB_TMO])) break; if (sp > XB_SPIN_CAP) { atomicAdd(&bar[XB_TMO], 1u); break; } }
    }
    nloc = mine > 0u ? mine : 1u; nx = cnt > 0u ? cnt : 1u;
}
__device__ __forceinline__ void xcd_barrier(const XcdBarrier& b) {
    asm volatile("s_waitcnt vmcnt(0)" ::: "memory");
    __syncthreads();
    if (threadIdx.x == 0) {
        unsigned* bar = b.bar;
        __builtin_amdgcn_s_waitcnt(0);
        unsigned nloc = b.st[0], nx = b.st[1];
        if (nloc == 0u) { xcd_barrier_complete(bar, b.x, nloc, nx); b.st[0] = nloc; b.st[1] = nx; }
        const unsigned old = xb_add(&bar[XB_XSUB(b.x)], 1u);
        const unsigned gen = old / nloc;
        if (old + 1u == (gen + 1u) * nloc) {
            __builtin_amdgcn_fence(__ATOMIC_RELEASE, "agent");
            asm volatile("s_waitcnt vmcnt(0)" ::: "memory");
            const unsigned og = xb_add(&bar[XB_TOP], 1u);
            const unsigned tg = og / nx;
            if (og + 1u == (tg + 1u) * nx) xb_add(&bar[XB_TOPGEN], 1u);
            else XB_SPIN(xb_ld(&bar[XB_TOPGEN]) == tg, bar);
            __builtin_amdgcn_fence(__ATOMIC_ACQUIRE, "agent");
            xb_add(&bar[XB_XGEN(b.x)], 1u);
            asm volatile("s_waitcnt vmcnt(0)" ::: "memory");
        } else {
            XB_SPIN(xb_ld(&bar[XB_XGEN(b.x)]) == gen, bar);
            __builtin_amdgcn_fence(__ATOMIC_ACQUIRE, "agent");
            asm volatile("s_waitcnt vmcnt(0)" ::: "memory");
        }
    }
    __syncthreads();
}

__device__ __forceinline__ bf16_t* w1_row(unsigned char* ws, int c) {
    int r; bf16_t* base = (bf16_t*)(ws + WS_W1);
    if (c < 6144) r = c;
    else if (c < 6160) r = 44 * 256 + 80 + (c - 6144);
    else if (c < 10256) r = 6144 + (c - 6160);
    else if (c < 10320) r = 44 * 256 + (c - 10256);
    else if (c < 10336) r = 44 * 256 + 64 + (c - 10320);
    else if (c < 11360) r = 10240 + (c - 10336);
    else return nullptr;
    return base + (size_t)r * 2048;
}
struct RowLin { bf16_t* d; size_t pitch; __device__ __forceinline__ bf16_t* operator()(int n) const { return d + (size_t)n * pitch; } };
struct RowLin8 { unsigned char* d; size_t pitch; __device__ __forceinline__ unsigned char* operator()(int n) const { return d + (size_t)n * pitch; } };
template <class RowFn>
__device__ __forceinline__ void transpose_item8(const float* W, int N, LAS float* scr, int item, int lane, RowFn rowp, float scale) {
    const int nblk = N / 32, kb = item / nblk, nb = item % nblk, k0 = 64 * kb, n0 = 32 * nb;
#pragma unroll
    for (int i = 0; i < 8; ++i) { const int kk = 8 * i + (lane >> 3), n4 = (lane & 7) * 4; const f32x4 v = *(const f32x4*)(W + (size_t)(k0 + kk) * N + n0 + n4);
        LAS float* d = scr + kk * 33 + n4; d[0] = v[0]; d[1] = v[1]; d[2] = v[2]; d[3] = v[3]; }
    LDS_WAIT(); asm volatile("" ::: "memory");
    const int c = lane & 7;
#pragma unroll
    for (int j = 0; j < 4; ++j) { const int n = (lane >> 3) + 8 * j; const LAS float* sp = scr + (8 * c) * 33 + n;
        *(u32x2*)(rowp(n0 + n) + k0 + 8 * c) = (u32x2){pk_fp8x4(sp[0 * 33] * scale, sp[1 * 33] * scale, sp[2 * 33] * scale, sp[3 * 33] * scale), pk_fp8x4(sp[4 * 33] * scale, sp[5 * 33] * scale, sp[6 * 33] * scale, sp[7 * 33] * scale)}; }
    LDS_WAIT(); asm volatile("" ::: "memory");
}
__device__ __forceinline__ bool w1_is_bf16(int c) { return (c >= 6144 && c < 6160) || (c >= 9232 && c < 10336); }
__device__ __forceinline__ void transpose_item_w1(const float* W, LAS float* scr, int item, int lane, unsigned char* ws) {
    constexpr int N = IN_W; const int nblk = N / 32, kb = item / nblk, nb = item % nblk, k0 = 64 * kb, n0 = 32 * nb;
#pragma unroll
    for (int i = 0; i < 8; ++i) { const int kk = 8 * i + (lane >> 3), n4 = (lane & 7) * 4; const f32x4 v = *(const f32x4*)(W + (size_t)(k0 + kk) * N + n0 + n4);
        LAS float* d = scr + kk * 33 + n4; d[0] = v[0]; d[1] = v[1]; d[2] = v[2]; d[3] = v[3]; }
    LDS_WAIT(); asm volatile("" ::: "memory");
    const int c = lane & 7;
#pragma unroll
    for (int j = 0; j < 4; ++j) { const int n = (lane >> 3) + 8 * j; const LAS float* sp = scr + (8 * c) * 33 + n; bf16_t* rp = w1_row(ws, n0 + n);
        if (w1_is_bf16(n0 + n)) { u32x4 o; o.x = pk2(sp[0 * 33], sp[1 * 33]); o.y = pk2(sp[2 * 33], sp[3 * 33]); o.z = pk2(sp[4 * 33], sp[5 * 33]); o.w = pk2(sp[6 * 33], sp[7 * 33]); *(u32x4*)(rp + k0 + 8 * c) = o; }
        else *(u32x2*)((unsigned char*)rp + k0 + 8 * c) = (u32x2){pk_fp8x4(sp[0 * 33] * W1_SCALE, sp[1 * 33] * W1_SCALE, sp[2 * 33] * W1_SCALE, sp[3 * 33] * W1_SCALE), pk_fp8x4(sp[4 * 33] * W1_SCALE, sp[5 * 33] * W1_SCALE, sp[6 * 33] * W1_SCALE, sp[7 * 33] * W1_SCALE)}; }
    LDS_WAIT(); asm volatile("" ::: "memory");
}
template <class RowFn>
__device__ __forceinline__ void transpose_item(const float* W, int N, LAS float* scr, int item, int lane, RowFn rowp) {
    const int nblk = N / 32, kb = item / nblk, nb = item % nblk, k0 = 64 * kb, n0 = 32 * nb;
#pragma unroll
    for (int i = 0; i < 8; ++i) { const int kk = 8 * i + (lane >> 3), n4 = (lane & 7) * 4; const f32x4 v = *(const f32x4*)(W + (size_t)(k0 + kk) * N + n0 + n4);
        LAS float* d = scr + kk * 33 + n4; d[0] = v[0]; d[1] = v[1]; d[2] = v[2]; d[3] = v[3]; }
    LDS_WAIT(); asm volatile("" ::: "memory");
    const int c = lane & 7;
#pragma unroll
    for (int j = 0; j < 4; ++j) { const int n = (lane >> 3) + 8 * j; const LAS float* s = scr + (8 * c) * 33 + n;
        u32x4 o; o.x = pk2(s[0 * 33], s[1 * 33]); o.y = pk2(s[2 * 33], s[3 * 33]); o.z = pk2(s[4 * 33], s[5 * 33]); o.w = pk2(s[6 * 33], s[7 * 33]);
        *(u32x4*)(rowp(n0 + n) + k0 + 8 * c) = o; }
    LDS_WAIT(); asm volatile("" ::: "memory");
}
__device__ __forceinline__ void cvt_rows(const float* src, bf16_t* dst, size_t n8, size_t i0, size_t stride) {
    for (size_t i = i0; i < n8; i += stride) { const f32x4 a = ((const f32x4*)src)[2 * i], b = ((const f32x4*)src)[2 * i + 1];
        u32x4 o; o.x = pk2(a[0], a[1]); o.y = pk2(a[2], a[3]); o.z = pk2(b[0], b[1]); o.w = pk2(b[2], b[3]); ((u32x4*)dst)[i] = o; }
}
__device__ __forceinline__ void ph_prologue(const Args& a, LAS unsigned char* lds, int bid, int nblk) {
    unsigned char* ws = a.ws; const int tid = threadIdx.x, lane = tid & 63, wave = __builtin_amdgcn_readfirstlane(tid >> 6);
    const size_t g0 = (size_t)bid * 512 + tid, gs = (size_t)nblk * 512;
    { const float* src = a.in[I_X]; bf16_t* dst = (bf16_t*)(ws + WS_XB); unsigned char* dq = ws + WS_XQ;
      for (size_t i = g0; i < (size_t)M * D / 8; i += gs) { const f32x4 p = ((const f32x4*)src)[2 * i], q = ((const f32x4*)src)[2 * i + 1];
          u32x4 o; o.x = pk2(p[0], p[1]); o.y = pk2(p[2], p[3]); o.z = pk2(q[0], q[1]); o.w = pk2(q[2], q[3]); ((u32x4*)dst)[i] = o;
          ((u32x2*)dq)[i] = (u32x2){pk_fp8x4(p[0], p[1], p[2], p[3]), pk_fp8x4(q[0], q[1], q[2], q[3])}; } }
    cvt_rows(a.in[I_MEM], (bf16_t*)(ws + WS_MEMB), (size_t)BATCH * NMEM * D / 8, g0, gs);
    { u32x4* z = (u32x4*)((bf16_t*)(ws + WS_W1) + (size_t)(44 * 256 + 96) * 2048); const u32x4 zero = {0u, 0u, 0u, 0u};
      for (size_t i = g0; i < (size_t)160 * 2048 / 8; i += gs) z[i] = zero; }
    LAS float* scr = (LAS float*)(lds + wave * 8448);
    const int gw = bid * 8 + wave, NGW = nblk * 8;
    constexpr int I_1 = 32 * (IN_W / 32), I_BG = 32 * 64, I_BD = 16 * 64, I_BM = 16 * 64, I_O = 32 * 64, I_UP = 32 * 256, I_DN = 128 * 64, I_KV = 32 * 64;
    constexpr int NITEMS = I_1 + I_BG + I_BD + I_BM + I_O + I_UP + I_DN + I_KV;
    for (int it = gw; it < NITEMS; it += NGW) {
        int r = it;
        if (r < I_1) { if ((r % (IN_W / 32)) * 32 >= 11360) transpose_item8(a.in[I_WIN], IN_W, scr, r, lane, RowLin8{ws + WS_WG - (size_t)11360 * 2048, 2048}, WG_SCALE);
                       else transpose_item_w1(a.in[I_WIN], scr, r, lane, ws); continue; } r -= I_1;
        if (r < I_BG) { transpose_item8(a.in[I_WBG], 2048, scr, r, lane, RowLin8{ws + WS_BRG, 2048}, WB_SCALE); continue; } r -= I_BG;
        if (r < I_BD) { transpose_item8(a.in[I_WBD], 2048, scr, r, lane, RowLin8{ws + WS_BRDM, 2048}, WB_SCALE); continue; } r -= I_BD;
        if (r < I_BM) { transpose_item8(a.in[I_WBM], 2048, scr, r, lane, RowLin8{ws + WS_BRDM + 1024, 2048}, WB_SCALE); continue; } r -= I_BM;
        if (r < I_O) { transpose_item8(a.in[I_WO], 2048, scr, r, lane, RowLin8{ws + WS_WO, 2048}, WO_SCALE); continue; } r -= I_O;
        if (r < I_UP) { transpose_item8(a.in[I_WUP], 8192, scr, r, lane, RowLin8{ws + WS_WUP, 2048}, WU_SCALE); continue; } r -= I_UP;
        if (r < I_DN) { transpose_item8(a.in[I_WDOWN], 2048, scr, r, lane, RowLin8{ws + WS_WDOWN, 8192}, WD_SCALE); continue; } r -= I_DN;
        { transpose_item(a.in[I_WMKV], 2048, scr, r, lane, RowLin{(bf16_t*)(ws + WS_WMKV), 2048}); }
    }
}

__device__ __forceinline__ void ph_gla_prep(const Args& a, LAS unsigned char* lds, int bid, int nblk) {
    unsigned char* ws = a.ws; const int tid = threadIdx.x, lane = tid & 63, wave = __builtin_amdgcn_readfirstlane(tid >> 6);
    LAS float* bcum = (LAS float*)lds;
    LAS bf16_t* qs = (LAS bf16_t*)(lds + 65536);
    LAS bf16_t* ks = (LAS bf16_t*)(lds + 65536 + 33792);
    LAS float* glr = (LAS float*)(lds + 65536 + 2 * 33792);
    bf16_t* GQ = (bf16_t*)((unsigned char*)a.out + DO_GQ); const bf16_t* GK = (const bf16_t*)((unsigned char*)a.out + DO_GK);
    const float* SMF = (const float*)(ws + WS_SMF); bf16_t* KT = (bf16_t*)(ws + WS_KT); bf16_t* AM = (bf16_t*)(ws + WS_AM); float* DEC = (float*)(ws + WS_DEC);
    const float* wgu = a.in[I_WGU]; const float* bgv = a.in[I_BG];
    for (int item = bid; item < BATCH * NCHUNK * 4; item += nblk) {
        const int h = item & 3, bn = item >> 2, b = bn / NCHUNK, n = bn % NCHUNK; const size_t t0 = (size_t)b * T + (size_t)n * 64;
        for (int i = tid; i < 1024; i += 512) glr[i] = SMF[(t0 + (i >> 4)) * 256 + 80 + (i & 15)];
        __syncthreads();
        const int d = tid & 255, half = tid >> 8, col = h * 256 + d;
        float wu[16];
#pragma unroll
        for (int r = 0; r < 16; ++r) wu[r] = wgu[r * 1024 + col];
        const float bg = bgv[col];
        float run = 0.f;
        for (int cc = 0; cc < 32; ++cc) { const int c = half * 32 + cc; float z = bg;
#pragma unroll
            for (int r = 0; r < 16; ++r) z += glr[c * 16 + r] * wu[r];
            const float ls = fminf(z, 0.f) - __logf(1.f + __expf(-fabsf(z)));
            run += ls * (1.0f / 16.0f); bcum[c * 256 + d] = run; }
        __syncthreads();
        const float first = bcum[31 * 256 + d], b_ref = first + bcum[32 * 256 + d], b_last = first + bcum[63 * 256 + d];
        unsigned kst[16];
#pragma unroll
        for (int c8 = 0; c8 < 4; ++c8) {
            unsigned short qraw[8], kraw[8];
#pragma unroll
            for (int e = 0; e < 8; ++e) { const size_t gi = (t0 + half * 32 + c8 * 8 + e) * 1024 + col; qraw[e] = GQ[gi]; kraw[e] = GK[gi]; }
#pragma unroll
            for (int e = 0; e < 8; ++e) { const int cc = c8 * 8 + e, c = half * 32 + cc; const float bt = bcum[c * 256 + d] + (half ? first : 0.f);
                const size_t gi = (t0 + c) * 1024 + col;
                const float q = bf2f(qraw[e]) * 0.0625f, k = bf2f(kraw[e]);
                qs[c * 264 + d] = (bf16_t)f2bf(q * __expf(bt - b_ref)); ks[c * 264 + d] = (bf16_t)f2bf(k * __expf(b_ref - bt));
                GQ[gi] = (bf16_t)f2bf(q * __expf(bt));
                const unsigned kv = f2bf(k * __expf(b_last - bt));
                if (cc & 1) kst[cc >> 1] |= kv << 16; else kst[cc >> 1] = kv; } }
        { u32x4* kp = (u32x4*)(KT + (size_t)item * 16384 + d * 64 + half * 32);
#pragma unroll
          for (int j = 0; j < 4; ++j) kp[j] = (u32x4){kst[4 * j], kst[4 * j + 1], kst[4 * j + 2], kst[4 * j + 3]}; }
        if (half == 0) DEC[(size_t)item * 256 + d] = __expf(b_last);
        __syncthreads();
        { const int mt = wave >> 1, fr = lane & 15, fq = lane >> 4;
#pragma unroll
          for (int nn = 0; nn < 2; ++nn) { const int ntl = (wave & 1) * 2 + nn; f32x4 acc = {0.f, 0.f, 0.f, 0.f};
#pragma unroll
              for (int k8 = 0; k8 < 8; ++k8) { const bf16x8 av = *(const LAS bf16x8*)(qs + (mt * 16 + fr) * 264 + k8 * 32 + fq * 8), bv = *(const LAS bf16x8*)(ks + (ntl * 16 + fr) * 264 + k8 * 32 + fq * 8);
                  acc = __builtin_amdgcn_mfma_f32_16x16x32_bf16(av, bv, acc, 0, 0, 0); }
#pragma unroll
              for (int i = 0; i < 4; ++i) { const int tok = mt * 16 + fq * 4 + i, s = ntl * 16 + fr; AM[(size_t)item * 4096 + tok * 64 + s] = (bf16_t)f2bf(s <= tok ? acc[i] : 0.f); } } }
        __syncthreads();
    }
}
struct ScanOps { u32x2 q[4][2]; bf16x8 k[2][2]; f32x4 dec[2]; bf16x8 af; u32x4 v; };
struct ScanOff { unsigned q, k, dec, af, v; };
__device__ __forceinline__ void scan_load(ScanOps& X, const ScanOff& O, const bf16_t* GQ, const bf16_t* GV, const bf16_t* KT, const bf16_t* AM, const float* DEC, int b, int h, int sl, int n, int w, int tid) {
    const size_t item = ((size_t)b * NCHUNK + n) * 4 + h, t0 = (size_t)b * T + (size_t)n * 64;
    const char* qb = (const char*)(GQ + t0 * 1024 + h * 256 + 32 * w); const char* kb = (const char*)(KT + item * 16384 + (size_t)(32 * w) * 64);
    const char* db = (const char*)(DEC + item * 256 + 32 * w); const char* ab = (const char*)(AM + item * 4096 + (size_t)((w >> 1) * 16) * 64 + 32 * (w & 1)); const char* vb = (const char*)(GV + t0 * 2048 + h * 512 + sl * 32);
#pragma unroll
    for (int mt = 0; mt < 4; ++mt) { X.q[mt][0] = *(const u32x2*)(qb + O.q + mt * 16 * 2048); X.q[mt][1] = *(const u32x2*)(qb + O.q + mt * 16 * 2048 + 32); }
#pragma unroll
    for (int i = 0; i < 2; ++i) { X.k[i][0] = *(const bf16x8*)(kb + O.k + i * 16 * 128); X.k[i][1] = *(const bf16x8*)(kb + O.k + i * 16 * 128 + 64); X.dec[i] = *(const f32x4*)(db + O.dec + i * 64); }
    X.af = *(const bf16x8*)(ab + O.af);
    if (tid < 256) X.v = *(const u32x4*)(vb + O.v);
}
__device__ __forceinline__ void scan_put_v(const ScanOps& X, LAS unsigned char* vt, int tid) {
    if (tid < 256) { const int tok = tid >> 2, c0 = 8 * (tid & 3); const unsigned w[4] = {X.v.x, X.v.y, X.v.z, X.v.w};
#pragma unroll
        for (int c = 0; c < 8; ++c) *(LAS unsigned short*)(vt + (c0 + c) * 144 + tok * 2) = (unsigned short)((c & 1) ? (w[c >> 1] >> 16) : (w[c >> 1] & 0xffffu)); }
}
__device__ __forceinline__ void ph_gla_scan(const Args& a, LAS unsigned char* lds, int bid, int nblk) {
    unsigned char* ws = a.ws; const int tid = threadIdx.x, lane = tid & 63, w = __builtin_amdgcn_readfirstlane(tid >> 6), fr = lane & 15, fq = lane >> 4;
    LAS unsigned char* vtb = lds;
    LAS float* red = (LAS float*)(lds + 9216);
    constexpr int RED_W = 8 * 256, RED_B = 8 * RED_W;
    const bf16_t* GQ = (const bf16_t*)((unsigned char*)a.out + DO_GQ); bf16_t* GV = (bf16_t*)((unsigned char*)a.out + DO_GV);
    const bf16_t* KT = (const bf16_t*)(ws + WS_KT); const bf16_t* AM = (const bf16_t*)(ws + WS_AM); const float* DEC = (const float*)(ws + WS_DEC);
    for (int task = bid; task < 128; task += nblk) {
        const int b = task >> 6, h = (task >> 4) & 3, sl = task & 15;
        f32x4 S[2][2];
#pragma unroll
        for (int i = 0; i < 2; ++i)
#pragma unroll
            for (int j = 0; j < 2; ++j) S[i][j] = (f32x4){0.f, 0.f, 0.f, 0.f};
        ScanOps oa, ob, oc;
        const ScanOff SO{(unsigned)(fr * 2048 + 8 * fq), (unsigned)(fr * 128 + 16 * fq), (unsigned)(16 * fq), (unsigned)(fr * 128 + 16 * fq), (unsigned)((tid >> 2) * 4096 + 16 * (tid & 3))};
        scan_load(oa, SO, GQ, GV, KT, AM, DEC, b, h, sl, 0, w, tid);
        scan_load(ob, SO, GQ, GV, KT, AM, DEC, b, h, sl, 1, w, tid);
        scan_put_v(oa, vtb, tid);
        WG_BAR_LDS();
#define SCAN_STEP(CUR, NXT, FAR, n) do {                                                                                                             \
            { const int nf = (n) + 2 < NCHUNK ? (n) + 2 : NCHUNK - 1; scan_load(FAR, SO, GQ, GV, KT, AM, DEC, b, h, sl, nf, w, tid); }               \
            LAS unsigned char* vt = vtb + ((n) & 1) * 4608; LAS float* rb = red + ((n) & 1) * RED_B;                                                 \
            _Pragma("unroll") for (int j = 0; j < 2; ++j) {                                                                                          \
                const bf16x8 vf0 = *(const LAS bf16x8*)(vt + (16 * j + fr) * 144 + (8 * fq) * 2), vf1 = *(const LAS bf16x8*)(vt + (16 * j + fr) * 144 + (32 + 8 * fq) * 2); \
                const u32x4 sw = {cvt_pk_bf16(S[0][j][0], S[0][j][1]), cvt_pk_bf16(S[0][j][2], S[0][j][3]), cvt_pk_bf16(S[1][j][0], S[1][j][1]), cvt_pk_bf16(S[1][j][2], S[1][j][3])}; \
                const bf16x8 Sb = __builtin_bit_cast(bf16x8, sw);                                                                                    \
                const f32x4 z = {0.f, 0.f, 0.f, 0.f}; const f32x4 ia = __builtin_amdgcn_mfma_f32_16x16x32_bf16(CUR.af, (w & 1) ? vf1 : vf0, z, 0, 0, 0); \
                _Pragma("unroll") for (int mt = 0; mt < 4; ++mt) { const u32x4 qw = {CUR.q[mt][0].x, CUR.q[mt][0].y, CUR.q[mt][1].x, CUR.q[mt][1].y}; \
                    f32x4 op = __builtin_amdgcn_mfma_f32_16x16x32_bf16(__builtin_bit_cast(bf16x8, qw), Sb, z, 0, 0, 0); if (mt == (w >> 1)) op += ia; \
                    *(LAS f32x4*)(rb + w * RED_W + (j * 4 + mt) * 256 + lane * 4) = op; }                                                          \
                _Pragma("unroll") for (int i = 0; i < 2; ++i) { S[i][j] = __builtin_amdgcn_mfma_f32_16x16x32_bf16(CUR.k[i][0], vf0, S[i][j] * CUR.dec[i], 0, 0, 0); \
                    S[i][j] = __builtin_amdgcn_mfma_f32_16x16x32_bf16(CUR.k[i][1], vf1, S[i][j], 0, 0, 0); } }                                     \
            scan_put_v(NXT, vtb + (((n) + 1) & 1) * 4608, tid);                                                                                      \
            WG_BAR_LDS();                                                                                                                            \
            { f32x4 acc = *(const LAS f32x4*)(rb + w * 256 + lane * 4);           \
              _Pragma("unroll") for (int ww = 1; ww < 8; ++ww) acc += *(const LAS f32x4*)(rb + ww * RED_W + w * 256 + lane * 4);                   \
              bf16_t* op_ = GV + ((size_t)b * T + (size_t)(n) * 64 + (w & 3) * 16 + 4 * fq) * 2048 + h * 512 + sl * 32 + (w >> 2) * 16 + fr;      \
              _Pragma("unroll") for (int i = 0; i < 4; ++i) op_[(size_t)i * 2048] = (bf16_t)f2bf(acc[i]); } } while (0)
#pragma unroll 1
        for (int n = 0; n < NCHUNK - 1; n += 3) {
            SCAN_STEP(oa, ob, oc, n);
            SCAN_STEP(ob, oc, oa, n + 1);
            SCAN_STEP(oc, oa, ob, n + 2);
        }
        SCAN_STEP(oa, ob, oc, NCHUNK - 1);
#undef SCAN_STEP
    }
}
__device__ __forceinline__ void ph_gla_final(const Args& a, int bid, int nblk) {
    unsigned char* ws = a.ws; const int tid = threadIdx.x, lane = tid & 63, wave = __builtin_amdgcn_readfirstlane(tid >> 6);
    const bf16_t* GV = (const bf16_t*)((unsigned char*)a.out + DO_GV); bf16_t* GR = (bf16_t*)(ws + WS_GR); const float* ng = a.in[I_NG];
    for (int it = bid * 8 + wave; it < M * 4; it += nblk * 8) { const size_t off = (size_t)(it >> 2) * 2048 + (it & 3) * 512 + 8 * lane;
        f32x4 o0, o1, r0, r1; unpack8(*(const u32x4*)(GV + off), o0, o1); unpack8(*(const u32x4*)(GR + off), r0, r1);
        float ss = (o0[0] * o0[0] + o0[1] * o0[1]) + (o0[2] * o0[2] + o0[3] * o0[3]) + (o1[0] * o1[0] + o1[1] * o1[1]) + (o1[2] * o1[2] + o1[3] * o1[3]);
        ss = wave_sum(ss); const float rs = 1.0f / sqrtf(ss * (1.0f / 512.0f) + RMS_EPS);
        const f32x4 g0 = *(const f32x4*)(ng + (it & 3) * 512 + 8 * lane), g1 = *(const f32x4*)(ng + (it & 3) * 512 + 8 * lane + 4);
#pragma unroll
        for (int j = 0; j < 4; ++j) { o0[j] = o0[j] * rs * g0[j] * (r0[j] / (1.f + __expf(-r0[j]))); o1[j] = o1[j] * rs * g1[j] * (r1[j] / (1.f + __expf(-r1[j]))); }
        *(u32x2*)((unsigned char*)a.out + DO_OGQ + off) = (u32x2){pk_fp8x4(o0[0], o0[1], o0[2], o0[3]), pk_fp8x4(o1[0], o1[1], o1[2], o1[3])}; }
    { const bf16_t* QDM = (const bf16_t*)(ws + WS_QDM); unsigned char* dq = (unsigned char*)a.out + DO_ODMQ;
      for (size_t i = (size_t)bid * 512 + tid; i < (size_t)M * 2048 / 8; i += (size_t)nblk * 512) { f32x4 p, q; unpack8(((const u32x4*)QDM)[i], p, q);
          const float sc = ((i & 255) >= 128) ? OMEM_SCALE : 1.0f;
          ((u32x2*)dq)[i] = (u32x2){pk_fp8x4(p[0] * sc, p[1] * sc, p[2] * sc, p[3] * sc), pk_fp8x4(q[0] * sc, q[1] * sc, q[2] * sc, q[3] * sc)}; } }
}

__device__ __forceinline__ void ph_dsa_norms(const Args& a, LAS unsigned char* lds, int bid, int nblk) {
    unsigned char* ws = a.ws; const int tid = threadIdx.x, lane = tid & 63, wave = __builtin_amdgcn_readfirstlane(tid >> 6);
    LAS float* wmax = (LAS float*)lds; LAS int* wid = (LAS int*)(lds + 256);
    for (int c0 = bid * 8; c0 < 2 * M / 32; c0 += nblk * 8) { const int chunk = c0 + wave; const int which = chunk >= M / 32, r0 = (which ? chunk - M / 32 : chunk) * 32, b = r0 / T;
        float mx = 0.f;
        for (int r = 0; r < 32; ++r) { const int row = r0 + r;
            const bf16_t* src = which ? (const bf16_t*)(ws + WS_DK) + (size_t)row * 1024 : (const bf16_t*)(ws + WS_QDM) + (size_t)row * 2048;
            f32x4 v0, v1, v2, v3; unpack8(*(const u32x4*)(src + 16 * lane), v0, v1); unpack8(*(const u32x4*)(src + 16 * lane + 8), v2, v3);
            const float ss = (v0[0] * v0[0] + v0[1] * v0[1]) + (v0[2] * v0[2] + v0[3] * v0[3]) + (v1[0] * v1[0] + v1[1] * v1[1]) + (v1[2] * v1[2] + v1[3] * v1[3])
                           + (v2[0] * v2[0] + v2[1] * v2[1]) + (v2[2] * v2[2] + v2[3] * v2[3]) + (v3[0] * v3[0] + v3[1] * v3[1]) + (v3[2] * v3[2] + v3[3] * v3[3]);
            float t = ss + __shfl_xor(ss, 1); t += __shfl_xor(t, 2); t += __shfl_xor(t, 4); mx = fmaxf(mx, t); }
        if ((lane & 7) == 0) wmax[wave * 8 + (lane >> 3)] = mx;
        if (lane == 0) wid[wave] = which * 2 + b;
        __syncthreads();
        if (tid < 32) { const int id = tid >> 3, h = tid & 7; float m = 0.f; bool any = false;
#pragma unroll
            for (int w = 0; w < 8; ++w) if (wid[w] == id) { m = fmaxf(m, wmax[w * 8 + h]); any = true; }
            if (any) __hip_atomic_fetch_max((unsigned*)(ws + WS_CTL) + CW_NRM + ((id & 1) * 8 + h) * 2 + (id >> 1), __builtin_bit_cast(unsigned, m), __ATOMIC_RELAXED, __HIP_MEMORY_SCOPE_AGENT); }
        __syncthreads();
    }
}
__device__ __forceinline__ int binf(float x, float lo, float iw) { int b = (int)((x - lo) * iw); b = b < 0 ? 0 : b; return b > 511 ? 511 : b; }
__device__ __forceinline__ void ph_dsa_index(const Args& a, LAS unsigned char* lds, int bid, int nblk) {
    unsigned char* ws = a.ws; const int tid = threadIdx.x, lane = tid & 63, wave = __builtin_amdgcn_readfirstlane(tid >> 6), hb = wave >> 2, wsm = wave & 3;
    LAS unsigned char* binb = lds;
    LAS unsigned* hist = (LAS unsigned*)(lds + 131072);
    LAS unsigned* mwl = (LAS unsigned*)(lds + 139264);
    LAS unsigned* cand_s = (LAS unsigned*)(lds + 155648);
    LAS float* cand_x = (LAS float*)(lds + 157696);
    LAS unsigned* misc = (LAS unsigned*)(lds + 159744);
    LAS float* part = (LAS float*)(lds + 160256);
    const bf16_t* IQ = (const bf16_t*)(ws + WS_IQ); const bf16_t* IKB = (const bf16_t*)(ws + WS_IKB); const bf16_t* SMB = (const bf16_t*)(ws + WS_SMB); const float* SMF = (const float*)(ws + WS_SMF);
    unsigned long long* MASK = (unsigned long long*)(ws + WS_SEL);
    const int hi = lane >> 5, c = lane & 31; const float INF = __builtin_inff();
    for (int it = bid; it < M / 8; it += nblk) {
        const int b = it & 1, j = it >> 1, jj = j >> 7, pl = (jj >> 1) * 128 + (j & 127), t0 = 8 * ((jj & 1) ? (T / 8 - 1 - pl) : pl); const size_t row0 = (size_t)b * T + t0 + 4 * hb;
        const int ntile = (t0 + 8 + 31) >> 5;
#pragma unroll
        for (int e = 0; e < 4; ++e) hist[tid + 512 * e] = 0u;
#pragma unroll
        for (int e = 0; e < 8; ++e) mwl[tid + 512 * e] = 0u;
        __syncthreads();
        const int qsel = (c >> 2) & 1, g = (c & 3) + 4 * (c >> 3);
        bf16x8 af0[4], af1[4];
#pragma unroll
        for (int kk = 0; kk < 4; ++kk) { af0[kk] = *(const bf16x8*)(IQ + (row0 + qsel) * 1024 + g * 64 + 16 * kk + 8 * hi); af1[kk] = *(const bf16x8*)(IQ + (row0 + 2 + qsel) * 1024 + g * 64 + 16 * kk + 8 * hi); }
        float wv0[16], wv1[16];
#pragma unroll
        for (int i = 0; i < 16; ++i) { wv0[i] = SMF[(row0 + hi) * 256 + 64 + i] * 0.03125f; wv1[i] = SMF[(row0 + 2 + hi) * 256 + 64 + i] * 0.03125f; }
        const int tq0 = t0 + 4 * hb + hi, tq1 = tq0 + 2;
        const bf16_t* kp0 = IKB + (size_t)b * (T / 32) * 2048 + lane * 8;
#define D8_SCORE(ACC, WV, OUT) do { float s_ = 0.f; _Pragma("unroll") for (int i = 0; i < 16; ++i) { const float av = ACC[i]; const int ri = __float_as_int(av); s_ += WV[i] * __int_as_float(ri > 0 ? ri : 0); } OUT = s_; } while (0)
#define D8_MFMA(F) do { _Pragma("unroll") for (int i = 0; i < 16; ++i) { acc0[i] = 0.f; acc1[i] = 0.f; } \
            _Pragma("unroll") for (int kk = 0; kk < 4; ++kk) { acc0 = __builtin_amdgcn_mfma_f32_32x32x16_bf16(af0[kk], F[kk], acc0, 0, 0, 0); acc1 = __builtin_amdgcn_mfma_f32_32x32x16_bf16(af1[kk], F[kk], acc1, 0, 0, 0); } } while (0)
        const bool all_sel = t0 + 8 <= 256;
        float lo0 = 0.f, iw0 = 0.f, lo1 = 0.f, iw1 = 0.f;
        if (!all_sel) {
            float sm0 = 0.f, sm1 = 0.f, cn0 = 0.f, cn1 = 0.f, mx0 = -INF, mx1 = -INF;
#pragma unroll
            for (int u = 0; u < 2; ++u) { const int tile = ((wsm + 4 * u) * ntile) >> 3; const bf16_t* kp = kp0 + (size_t)tile * 2048; bf16x8 F[4];
#pragma unroll
                for (int kk = 0; kk < 4; ++kk) F[kk] = *(const bf16x8*)(kp + 512 * kk);
                f32x16 acc0, acc1; D8_MFMA(F); float s0, s1; D8_SCORE(acc0, wv0, s0); D8_SCORE(acc1, wv1, s1); const int s = tile * 32 + c;
                if (s <= tq0) { sm0 += s0; cn0 += 1.f; mx0 = fmaxf(mx0, s0); } if (s <= tq1) { sm1 += s1; cn1 += 1.f; mx1 = fmaxf(mx1, s1); } }
#pragma unroll
            for (int o = 1; o < 32; o <<= 1) { sm0 += __shfl_xor(sm0, o); cn0 += __shfl_xor(cn0, o); mx0 = fmaxf(mx0, __shfl_xor(mx0, o)); sm1 += __shfl_xor(sm1, o); cn1 += __shfl_xor(cn1, o); mx1 = fmaxf(mx1, __shfl_xor(mx1, o)); }
            if (c == 0) { LAS float* p0 = part + (wave * 4 + hi) * 4; p0[0] = sm0; p0[1] = cn0; p0[2] = mx0; LAS float* p1 = part + (wave * 4 + 2 + hi) * 4; p1[0] = sm1; p1[1] = cn1; p1[2] = mx1; }
            __syncthreads();
            { float s0 = 0.f, n0 = 0.f, m0 = -INF, s1 = 0.f, n1 = 0.f, m1 = -INF;
#pragma unroll
              for (int w2 = 0; w2 < 4; ++w2) { const LAS float* p0 = part + ((hb * 4 + w2) * 4 + hi) * 4; s0 += p0[0]; n0 += p0[1]; m0 = fmaxf(m0, p0[2]); const LAS float* p1 = part + ((hb * 4 + w2) * 4 + 2 + hi) * 4; s1 += p1[0]; n1 += p1[1]; m1 = fmaxf(m1, p1[2]); }
              const float me0 = s0 / fmaxf(n0, 1.f), me1 = s1 / fmaxf(n1, 1.f); const float h0 = m0 + 0.25f * (m0 - me0) + 1e-20f, h1 = m1 + 0.25f * (m1 - me1) + 1e-20f;
              lo0 = me0; iw0 = 254.f / (h0 - me0); lo1 = me1; iw1 = 254.f / (h1 - me1); }
            __syncthreads();
        }
        unsigned act0 = 1u, act1 = 1u;
#pragma unroll 1
        for (int pass = 0; pass < 8 && !all_sel; ++pass) {
            float smin0 = INF, smax0 = -INF, smin1 = INF, smax1 = -INF;
            const int ngrp = (ntile + 7) >> 3;
#define D8_LOAD(F, g) do { _Pragma("unroll") for (int u = 0; u < 2; ++u) { int tile = 8 * (g) + wsm + 4 * u; if (tile >= ntile) tile = 0; const bf16_t* kp = kp0 + (size_t)tile * 2048; \
                _Pragma("unroll") for (int kk = 0; kk < 4; ++kk) F[u][kk] = *(const bf16x8*)(kp + 512 * kk); } } while (0)
#define D8_BIN(SV, LO, IW, TQ, ACT, SMIN, SMAX, ROWP) do { const bool ok = s <= (tv ? TQ : -1); SMIN = ok ? fminf(SMIN, SV) : SMIN; SMAX = ok ? fmaxf(SMAX, SV) : SMAX; \
                int bn = (int)((SV - LO) * IW + 1.0f); bn = bn < 0 ? 0 : (bn > 255 ? 255 : bn); const int row = 4 * hb + (ROWP) + hi; \
                if (ok && ACT) { binb[row * 16384 + s] = (unsigned char)bn; if (bn != 0) __hip_atomic_fetch_add(hist + row * 256 + bn, 1u, __ATOMIC_RELAXED, __HIP_MEMORY_SCOPE_WORKGROUP); } } while (0)
#define D8_COMP(F, g) do { _Pragma("unroll") for (int u = 0; u < 2; ++u) { const int tile = 8 * (g) + wsm + 4 * u; const bool tv = tile < ntile; const int s = tile * 32 + c; f32x16 acc0, acc1; \
                D8_MFMA(F[u]); float s0, s1; D8_SCORE(acc0, wv0, s0); D8_SCORE(acc1, wv1, s1); \
                D8_BIN(s0, lo0, iw0, tq0, act0, smin0, smax0, 0); D8_BIN(s1, lo1, iw1, tq1, act1, smin1, smax1, 2); } } while (0)
            bf16x8 fa[2][4], fb[2][4];
            D8_LOAD(fa, 0);
#pragma unroll 1
            for (int g2 = 0; g2 < ngrp; g2 += 2) { D8_LOAD(fb, g2 + 1); D8_COMP(fa, g2); D8_LOAD(fa, g2 + 2); D8_COMP(fb, g2 + 1); }
#undef D8_LOAD
#undef D8_BIN
#undef D8_COMP
#pragma unroll
            for (int o = 1; o < 32; o <<= 1) { smin0 = fminf(smin0, __shfl_xor(smin0, o)); smax0 = fmaxf(smax0, __shfl_xor(smax0, o)); smin1 = fminf(smin1, __shfl_xor(smin1, o)); smax1 = fmaxf(smax1, __shfl_xor(smax1, o)); }
            if (c == 0) { LAS float* p0 = part + (wave * 4 + hi) * 4; p0[0] = smin0; p0[1] = smax0; LAS float* p1 = part + (wave * 4 + 2 + hi) * 4; p1[0] = smin1; p1[1] = smax1; }
            if (tid < 8) misc[tid * 16 + 2] = 0u;
            __syncthreads();
            { const int r = wave, rhb = r >> 2, rr = r & 3; const LAS unsigned* hq = hist + r * 256; LAS unsigned* mq = misc + r * 16; LAS float* mqf = (LAS float*)mq;
              const int nk = t0 + r + 1;
              float rlo, riw; { const bool mine = rhb == hb;            (void)mine;
                  const float l0 = __shfl(lo0, (rr & 1) * 32), i0 = __shfl(iw0, (rr & 1) * 32), l1 = __shfl(lo1, (rr & 1) * 32), i1 = __shfl(iw1, (rr & 1) * 32); rlo = (rr & 2) ? l1 : l0; riw = (rr & 2) ? i1 : i0; }
              const bool ract = __shfl((rr & 2) ? act1 : act0, (rr & 1) * 32) != 0u;
              if (ract) {
                  unsigned cb[4], v = 0u;
#pragma unroll
                  for (int e = 0; e < 4; ++e) { cb[e] = hq[4 * lane + e]; v += cb[e]; }
                  if (lane == 0) { v -= cb[0]; cb[0] = 0u; }
#pragma unroll
                  for (int off = 1; off < 64; off <<= 1) { const unsigned x = __shfl_down(v, off); if (lane + off < 64) v += x; }
                  const unsigned total = __shfl(v, 0);
                  unsigned above = v - (cb[0] + cb[1] + cb[2] + cb[3]); int Bf = -1; unsigned kf = 0u, cf = 0u;
#pragma unroll
                  for (int e = 3; e >= 0; --e) { if (above < 256u && 256u <= above + cb[e]) { Bf = 4 * lane + e; kf = 256u - above; cf = cb[e]; } above += cb[e]; }
                  const unsigned long long bal = __ballot(Bf >= 0); int B = -1; unsigned kq = 0u, cB = 0u;
                  if (bal) { const int src = __ffsll((long long)bal) - 1; B = __shfl(Bf, src); kq = __shfl(kf, src); cB = __shfl(cf, src); }
                  float tmin = INF, tmax = -INF;
#pragma unroll
                  for (int w2 = 0; w2 < 4; ++w2) { const LAS float* p = part + ((rhb * 4 + w2) * 4 + rr) * 4; tmin = fminf(tmin, p[0]); tmax = fmaxf(tmax, p[1]); }
                  float nlo = rlo, nhi = rlo; bool again = false;
                  if (total < 256u) { again = true; nlo = tmin; nhi = rlo; }
                  else if (cB > 64u) { again = true; const float wdt = 1.0f / riw;
                      if (B == 255) { nlo = rlo + 253.99f * wdt; nhi = tmax; } else { nlo = rlo + ((float)B - 1.01f) * wdt; nhi = rlo + ((float)B + 0.01f) * wdt; } }
                  if (again && !(nhi > nlo)) { again = false; if (total < 256u) { B = 0; kq = 256u - total; cB = 65u; } }
                  if (lane == 0) { if (again) { const float span = nhi - nlo; mqf[0] = nlo - 1e-3f * span; mqf[1] = 254.f / (span * 1.002f); mq[2] = 1u; } mq[4] = (unsigned)B; mq[5] = kq; mq[6] = cB; }
              }
            }
            __syncthreads();
            unsigned any = 0u;
#pragma unroll
            for (int r = 0; r < 8; ++r) any |= misc[r * 16 + 2];
            { const int r0 = 4 * hb + hi, r1 = r0 + 2; const LAS float* m0 = (const LAS float*)(misc + r0 * 16); const LAS float* m1 = (const LAS float*)(misc + r1 * 16);
              act0 = misc[r0 * 16 + 2]; act1 = misc[r1 * 16 + 2]; if (act0) { lo0 = m0[0]; iw0 = m0[1]; } if (act1) { lo1 = m1[0]; iw1 = m1[1]; } }
            if (any == 0u) break;
            { const int r = tid >> 6; if (misc[r * 16 + 2]) {
#pragma unroll
                for (int e = 0; e < 4; ++e) hist[r * 256 + lane + 64 * e] = 0u; } }
            __syncthreads();
        }
        { const int r = wave, rr = r & 3, nk = t0 + r + 1; LAS unsigned* mq = misc + r * 16; LAS unsigned* mwq = mwl + r * 512; const LAS unsigned char* bq = binb + r * 16384;
          unsigned nearv = 0u;
#define D8_MARK(s) do { __hip_atomic_fetch_or(mwq + ((s) >> 5), 1u << ((s) & 31), __ATOMIC_RELAXED, __HIP_MEMORY_SCOPE_WORKGROUP); nearv = nearv > (unsigned)(s) ? nearv : (unsigned)(s); } while (0)
          if (all_sel) { for (int s = lane; s < nk; s += 64) D8_MARK(s); }
          else {
              const int B = (int)mq[4]; const unsigned kq = mq[5], cB = mq[6];
              if (lane == 0) mq[3] = 0u;
              LDS_WAIT(); asm volatile("" ::: "memory");
              const int nk16 = (nk + 15) >> 4;
              for (int i16 = lane; i16 < nk16; i16 += 64) { const u32x4 wv4 = *(const LAS u32x4*)(bq + 16 * i16); const unsigned wq[4] = {wv4.x, wv4.y, wv4.z, wv4.w};
#pragma unroll
                  for (int e = 0; e < 16; ++e) { const int s = 16 * i16 + e; const int bn = (int)((wq[e >> 2] >> (8 * (e & 3))) & 255u);
                      if (s < nk) { if (bn > B) D8_MARK(s); else if (bn == B && cB <= 64u) { const unsigned pos = __hip_atomic_fetch_add(mq + 3, 1u, __ATOMIC_RELAXED, __HIP_MEMORY_SCOPE_WORKGROUP); if (pos < 64u) cand_s[r * 64 + pos] = (unsigned)s; } } } }
              LDS_WAIT(); asm volatile("" ::: "memory");
              if (cB <= 64u) {
                  const unsigned cc = mq[3];
                  const bool second = (rr & 2) != 0;
#pragma unroll
                  for (int t2 = 0; t2 < 2; ++t2) { if ((unsigned)(32 * t2) < cc) { const unsigned ci = 32u * t2 + (unsigned)c; const unsigned sk = ci < cc ? cand_s[r * 64 + ci] : 0u;
                          const bf16_t* kp = SMB + ((size_t)b * T + sk) * 256 + 8 * hi; bf16x8 F[4];
#pragma unroll
                          for (int kk = 0; kk < 4; ++kk) F[kk] = *(const bf16x8*)(kp + 16 * kk);
                          f32x16 acc0, acc1; D8_MFMA(F); float s0, s1; D8_SCORE(acc0, wv0, s0); D8_SCORE(acc1, wv1, s1);
                          if (hi == (rr & 1) && ci < cc) cand_x[r * 64 + ci] = second ? s1 : s0; } }
                  LDS_WAIT(); asm volatile("" ::: "memory");
                  if ((unsigned)lane < cc) { const float xi = cand_x[r * 64 + lane]; const unsigned si = cand_s[r * 64 + lane]; unsigned rank = 0u;
                      for (unsigned jx = 0; jx < cc; ++jx) { const float xj = cand_x[r * 64 + jx]; const unsigned sj = cand_s[r * 64 + jx]; rank += (xj > xi || (xj == xi && sj < si)) ? 1u : 0u; }
                      if (rank < kq) D8_MARK(si); }
              } else if (lane == 0) {
                  unsigned left = kq;
                  for (int s = 0; s < nk && left; ++s) if ((int)bq[s] == B) { D8_MARK(s); --left; } }
          }
#undef D8_MARK
#pragma unroll
          for (int o = 1; o < 64; o <<= 1) { const unsigned x = __shfl_xor(nearv, o); nearv = nearv > x ? nearv : x; }
          LDS_WAIT(); asm volatile("" ::: "memory");
          { const int jmax = ((t0 >> 8) + 1) * 4;
            for (int jt = lane; jt < jmax; jt += 64) MASK[((size_t)b * 256 + jt) * T + t0 + r] = (unsigned long long)mwq[2 * jt] | ((unsigned long long)mwq[2 * jt + 1] << 32);
            if (lane == 0) __hip_atomic_fetch_max((unsigned*)(ws + WS_CTL) + CW_DNB + b * 64 + ((t0 + r) >> 8), (unsigned)(t0 + r) - nearv, __ATOMIC_RELAXED, __HIP_MEMORY_SCOPE_AGENT); }
        }
#undef D8_SCORE
#undef D8_MFMA
        __syncthreads();
    }
}
__device__ __forceinline__ int crow(int r, int hi) { return (r & 3) + 8 * (r >> 2) + 4 * hi; }
namespace dsa {
constexpr int DH = 128, PQ = 2048, PKV = 1024, NW = 8, QBLK = 32, KVBLK = 64, QB = NW * QBLK;
constexpr int SHM_V = KVBLK * DH * 2, SHM_K = KVBLK * DH * 2, LDS_NEED = 2 * SHM_V + 2 * SHM_K + NW * 64 * 4;
constexpr float SCALE = 0.08838834764831845f, THR = 8.f;
#define KSWZ(row, colB) ((row) * 256 + ((colB) ^ (((row) & 7) << 4)))
#define SBAR() __builtin_amdgcn_sched_barrier(0)
__device__ __forceinline__ int v_st(int k, int c) { const int kk = (k & ~0xC) | ((k & 4) << 1) | ((k & 8) >> 1); return ((kk >> 3) * 4 + (c >> 5)) * 512 + ((kk & 7) * 32 + (c & 31)) * 2; }
__device__ __forceinline__ int v_rd_base(int lane) { return ((lane & 3) << 3) | (((lane >> 2) & 3) << 6) | (((lane >> 4) & 1) << 5) | (((lane >> 5) & 1) << 8); }
constexpr int v_rd_off(int d0, int ks, int half) { return d0 * 512 + ks * 4096 + half * 2048; }
typedef short s16x4 __attribute__((ext_vector_type(4)));
__device__ __forceinline__ bf16x8 ld8(const bf16_t* p) { return *reinterpret_cast<const bf16x8*>(p); }
__device__ __forceinline__ void partialSM(f32x16& p0, f32x16& p1, float& m_reg, float& mn, float& alpha) {
    float pmax = p0[0]; for (int r = 1; r < 16; ++r) pmax = fmaxf(pmax, p0[r]); for (int r = 0; r < 16; ++r) pmax = fmaxf(pmax, p1[r]);
    { auto rr = __builtin_amdgcn_permlane32_swap(__float_as_uint(pmax), __float_as_uint(pmax), false, false);
      pmax = fmaxf(__uint_as_float(rr[0]), __uint_as_float(rr[1])); }
    constexpr float C2 = 1.4426950408889634f * SCALE;
    if (__builtin_expect(__all((pmax - m_reg) * SCALE <= THR), 1)) { mn = m_reg; alpha = 1.f; }
    else { mn = fmaxf(m_reg, pmax); alpha = __builtin_amdgcn_exp2f((m_reg - mn) * C2); m_reg = mn; }
    const float mnL = -mn * C2;
    for (int r = 0; r < 16; ++r) p0[r] = fmaf(p0[r], C2, mnL); for (int r = 0; r < 16; ++r) p1[r] = fmaf(p1[r], C2, mnL);
    for (int r = 0; r < 16; ++r) p0[r] = __builtin_amdgcn_exp2f(p0[r]);
}
__device__ __forceinline__ void finishSM(f32x16& p0, f32x16& p1, float alpha, float& l_reg, bf16x8& pa0, bf16x8& pa1, bf16x8& pa2, bf16x8& pa3) {
    for (int r = 0; r < 16; ++r) p1[r] = __builtin_amdgcn_exp2f(p1[r]);
    float ps = 0; for (int r = 0; r < 16; ++r) ps += p0[r]; for (int r = 0; r < 16; ++r) ps += p1[r];
    { auto rr = __builtin_amdgcn_permlane32_swap(__float_as_uint(ps), __float_as_uint(ps), false, false);
      ps = __uint_as_float(rr[0]) + __uint_as_float(rr[1]); }
    l_reg = l_reg * alpha + ps;
#define PK4(P, B_, OUT) do { unsigned a0 = cvt_pk_bf16(P[B_+0], P[B_+1]), a1 = cvt_pk_bf16(P[B_+2], P[B_+3]);                          \
        unsigned b0 = cvt_pk_bf16(P[B_+4], P[B_+5]), b1 = cvt_pk_bf16(P[B_+6], P[B_+7]);                                             \
        auto r0 = __builtin_amdgcn_permlane32_swap(a0, b0, false, false); auto r1 = __builtin_amdgcn_permlane32_swap(a1, b1, false, false); \
        u32x4 w = {r0[0], r1[0], r0[1], r1[1]}; OUT = *reinterpret_cast<bf16x8*>(&w); } while (0)
    PK4(p0, 0, pa0); PK4(p0, 8, pa1); PK4(p1, 0, pa2); PK4(p1, 8, pa3);
#undef PK4
}
template <int KB>
__device__ __forceinline__ void qkt(f32x16& p0, f32x16& p1, const char* K_lds, int r32, int hi, const bf16x8* qr, u32x2 mw, float base0, float slr) {
    const float NEG = -__builtin_inff(); const unsigned wl = mw.x >> (4 * hi), wh = mw.y >> (4 * hi); const float base1 = fmaf(32.f, slr, base0);
#pragma unroll
    for (int r = 0; r < 16; ++r) { const int cr = (r & 3) + 8 * (r >> 2);
        p0[r] = ((wl >> cr) & 1u) ? fmaf(slr, (float)cr, base0) : NEG; p1[r] = ((wh >> cr) & 1u) ? fmaf(slr, (float)cr, base1) : NEG; }
    const char* kb[4];
#pragma unroll
    for (int dd = 0; dd < 4; ++dd) kb[dd] = K_lds + KB * SHM_K + KSWZ(r32, (dd * 16 + hi * 8) * 2);
#pragma unroll
    for (int d0 = 0; d0 < 8; ++d0) { const char* a = kb[d0 & 3] + (d0 >> 2) * 128;
        bf16x8 b0 = *reinterpret_cast<const bf16x8*>(a);
        bf16x8 b1 = *reinterpret_cast<const bf16x8*>(a + 32 * 256);
        p0 = __builtin_amdgcn_mfma_f32_32x32x16_bf16(b0, qr[d0], p0, 0, 0, 0);
        p1 = __builtin_amdgcn_mfma_f32_32x32x16_bf16(b1, qr[d0], p1, 0, 0, 0); }
}
template <int VB>
__device__ __forceinline__ void pv_tile(f32x16* o, int vb0, bf16x8 pa0, bf16x8 pa1, bf16x8 pa2, bf16x8 pa3) {
#define TRRD(dst, off) asm volatile("ds_read_b64_tr_b16 %0, %1 offset:%2" : "=&v"(dst) : "v"(vb0), "i"(off) : "memory")
#define PV_D0(d0) do { s16x4 l0, l1, l2, l3, h0, h1, h2, h3; constexpr int b_ = VB * SHM_V + v_rd_off(d0, 0, 0); \
        TRRD(l0, b_); TRRD(h0, b_ + 2048); TRRD(l1, b_ + 4096); TRRD(h1, b_ + 6144); TRRD(l2, b_ + 8192); TRRD(h2, b_ + 10240); TRRD(l3, b_ + 12288); TRRD(h3, b_ + 14336); \
        asm volatile("s_waitcnt lgkmcnt(0)" ::: "memory"); SBAR();   \
        o[d0] = __builtin_amdgcn_mfma_f32_32x32x16_bf16(pa0, (bf16x8){l0[0], l0[1], l0[2], l0[3], h0[0], h0[1], h0[2], h0[3]}, o[d0], 0, 0, 0);   \
        o[d0] = __builtin_amdgcn_mfma_f32_32x32x16_bf16(pa1, (bf16x8){l1[0], l1[1], l1[2], l1[3], h1[0], h1[1], h1[2], h1[3]}, o[d0], 0, 0, 0);   \
        o[d0] = __builtin_amdgcn_mfma_f32_32x32x16_bf16(pa2, (bf16x8){l2[0], l2[1], l2[2], l2[3], h2[0], h2[1], h2[2], h2[3]}, o[d0], 0, 0, 0);   \
        o[d0] = __builtin_amdgcn_mfma_f32_32x32x16_bf16(pa3, (bf16x8){l3[0], l3[1], l3[2], l3[3], h3[0], h3[1], h3[2], h3[3]}, o[d0], 0, 0, 0); } while (0)
    PV_D0(0); PV_D0(1); PV_D0(2); PV_D0(3);
#undef PV_D0
#undef TRRD
}
struct BlockRef { const bf16_t* Q; const bf16_t* K; const bf16_t* V; bf16_t* O; const unsigned long long* MW; int P0; float slr; int jlo; };
struct Seam { bf16x8 qr[8]; bf16x8 st_v0, st_v1, st_k0, st_k1; u32x2 mwA; };
#define ROWK(p, k0, rr) ((p) + (size_t)((k0) + (rr)) * PKV + sc)
#define VMW() asm volatile("s_waitcnt vmcnt(0)" ::: "memory")
#define VMWN(n) asm volatile("s_waitcnt vmcnt(%0)" :: "i"(n) : "memory")
#define SLOAD_H(Kp, Vp, k0) do { S.st_v0 = ld8(ROWK(Vp, k0, sr)); S.st_v1 = ld8(ROWK(Vp, k0, 32 + sr)); S.st_k0 = ld8(ROWK(Kp, k0, sr)); S.st_k1 = ld8(ROWK(Kp, k0, 32 + sr)); } while (0)
#define SWRITE_HK(bf) do { *(bf16x8*)(K_lds + (bf) * SHM_K + kws) = S.st_k0; *(bf16x8*)(K_lds + (bf) * SHM_K + kws + 32 * 256) = S.st_k1; } while (0)
#define SWRITE_HV(bf) do { *(bf16x8*)(V_lds + (bf) * SHM_V + vst0) = S.st_v0; *(bf16x8*)(V_lds + (bf) * SHM_V + vst1) = S.st_v1; } while (0)
#define SWRITE_H(bf) do { SWRITE_HV(bf); SWRITE_HK(bf); } while (0)
#define MLOAD(ref, j, rowpos) (*(const u32x2*)((ref).MW + (size_t)(j) * T + (rowpos)))
__device__ __forceinline__ void prime(const BlockRef& cur, char* lds, Seam& S) {
    const int tid = threadIdx.x, wid = __builtin_amdgcn_readfirstlane(tid >> 6), lane = tid & 63, r32 = lane & 31, hi = lane >> 5;
    const int sr = tid >> 4, sc = (tid & 15) * 8, kws = KSWZ(sr, sc * 2); char* K_lds = lds + 2 * SHM_V;
#pragma unroll
    for (int d0 = 0; d0 < 8; ++d0) S.qr[d0] = ld8(cur.Q + (size_t)(wid * QBLK + r32) * PQ + d0 * 16 + hi * 8);
    SLOAD_H(cur.K, cur.V, cur.jlo * KVBLK); S.mwA = MLOAD(cur, cur.jlo, cur.P0 + wid * QBLK + r32); VMW(); SWRITE_HK(0);
    __syncthreads();
}
template <class NextFn>
__device__ __forceinline__ BlockRef block(const BlockRef& cur, const NextFn& next_ref, char* lds, Seam& S) {
    const int tid = threadIdx.x, wid = __builtin_amdgcn_readfirstlane(tid >> 6), lane = tid & 63, r32 = lane & 31, hi = lane >> 5;
    const int jlo = cur.jlo, NT = cur.P0 / KVBLK + 4 - jlo;
    const int tposq = cur.P0 + wid * QBLK + r32; const float slr = cur.slr, f0 = -slr * (float)(tposq - 4 * hi);
    char* V_lds = lds; char* K_lds = lds + 2 * SHM_V;
    float* wsf = (float*)(lds + 2 * SHM_V + 2 * SHM_K) + wid * 64; float* li_l = wsf, * al_l = wsf + 32;
    float m_reg = -1e30f, l_reg = 0; f32x16 o[4] = {};
    const int sr = tid >> 4, sc = (tid & 15) * 8, vst0 = v_st(sr, sc), vst1 = v_st(32 + sr, sc), kws = KSWZ(sr, sc * 2);
    const int vb0 = (int)(uintptr_t)V_lds + v_rd_base(lane);
    const bf16_t* Kh = cur.K; const bf16_t* Vh = cur.V;
#define RESC(a) do { if (__any((a) < 1.f)) { if (hi == 0) al_l[r32] = (a); asm volatile("s_waitcnt lgkmcnt(0)" ::: "memory");              \
                     for (int d_ = 0; d_ < 4; ++d_) for (int r = 0; r < 16; ++r) o[d_][r] *= al_l[crow(r, hi)]; } } while (0)
#define KBASE(t) ((jlo + (t)) * KVBLK)
#define BASE0(t) fmaf(slr, (float)KBASE(t), f0)
    f32x16 pA0, pA1, pB0, pB1; float mnA, mnB, alA, alB; bf16x8 pa0, pa1, pa2, pa3; u32x2 mwB;
    SWRITE_HV(0); SBAR();
    SLOAD_H(Kh, Vh, KBASE(1)); mwB = MLOAD(cur, jlo + 1, tposq);
    SBAR(); qkt<0>(pA0, pA1, K_lds, r32, hi, S.qr, S.mwA, BASE0(0), slr);
    partialSM(pA0, pA1, m_reg, mnA, alA);
    VMW(); SWRITE_H(1);
    __syncthreads();
#define HALF_STEP(PX0, PX1, mnX, alX, PY0, PY1, alY, t, KB, VB, SB, MWX, MWY) do {                                          \
        SBAR(); qkt<KB>(PX0, PX1, K_lds, r32, hi, S.qr, MWX, BASE0(t), slr);                                                \
        finishSM(PY0, PY1, alY, l_reg, pa0, pa1, pa2, pa3); SBAR();                                                           \
        if ((t) + 1 < NT) { SLOAD_H(Kh, Vh, KBASE((t) + 1)); MWY = MLOAD(cur, jlo + (t) + 1, tposq); SBAR(); }                   \
        pv_tile<VB>(o, vb0, pa0, pa1, pa2, pa3); partialSM(PX0, PX1, m_reg, mnX, alX);                                      \
        __syncthreads();                                                                                                      \
        if ((t) + 1 < NT) { VMW(); SWRITE_H(SB); }                                                                           \
        RESC(alX); __syncthreads(); } while (0)
    for (int t = 1; t + 1 < NT; t += 2) {
        HALF_STEP(pB0, pB1, mnB, alB, pA0, pA1, alA, t, 1, 0, 0, mwB, S.mwA);
        HALF_STEP(pA0, pA1, mnA, alA, pB0, pB1, alB, t + 1, 0, 1, 1, S.mwA, mwB);
    }
    SBAR(); qkt<1>(pB0, pB1, K_lds, r32, hi, S.qr, mwB, BASE0(NT - 1), slr); SBAR();
    const BlockRef nxt = next_ref(cur);
    SLOAD_H(nxt.K, nxt.V, nxt.jlo * KVBLK); S.mwA = MLOAD(nxt, nxt.jlo, nxt.P0 + wid * QBLK + r32); SBAR();
#pragma unroll
    for (int d0 = 0; d0 < 8; ++d0) S.qr[d0] = ld8(nxt.Q + (size_t)(wid * QBLK + r32) * PQ + d0 * 16 + hi * 8);
    SBAR();
    finishSM(pA0, pA1, alA, l_reg, pa0, pa1, pa2, pa3); SBAR();
    pv_tile<0>(o, vb0, pa0, pa1, pa2, pa3);
    partialSM(pB0, pB1, m_reg, mnB, alB); __syncthreads(); RESC(alB);
    finishSM(pB0, pB1, alB, l_reg, pa0, pa1, pa2, pa3); SBAR(); pv_tile<1>(o, vb0, pa0, pa1, pa2, pa3);
    SBAR(); VMWN(8); SWRITE_HK(0); SBAR();
    if (hi == 0) li_l[r32] = l_reg; asm volatile("s_waitcnt lgkmcnt(0)" ::: "memory");
    float rli[16];
#pragma unroll
    for (int r = 0; r < 16; ++r) rli[r] = __builtin_amdgcn_rcpf(li_l[crow(r, hi)]);
    bf16_t* Ow = cur.O + (size_t)(wid * QBLK) * PQ;
#pragma unroll
    for (int r = 0; r < 16; ++r) { const int orow = crow(r, hi);
#pragma unroll
        for (int d0 = 0; d0 < 4; ++d0) { const float v = o[d0][r] * rli[r]; const float vn = __shfl_xor(v, 1);
            if ((r32 & 1) == 0) *(unsigned*)(Ow + (size_t)orow * PQ + d0 * 32 + r32) = cvt_pk_bf16(v, vn); } }
    __syncthreads();
    return nxt;
#undef RESC
#undef KBASE
#undef BASE0
#undef HALF_STEP
}
#undef ROWK
#undef VMW
#undef VMWN
#undef SLOAD_H
#undef SWRITE_HK
#undef SWRITE_HV
#undef SWRITE_H
#undef MLOAD
}
__device__ __forceinline__ dsa::BlockRef dsa_ref(unsigned char* ws, int i) {
    const int qb = 63 - (i >> 4), h = 7 - ((i & 15) >> 1), b = i & 1;
    dsa::BlockRef r; bf16_t* q = (bf16_t*)(ws + WS_QDM) + ((size_t)b * T + (size_t)qb * 256) * 2048 + h * 128;
    r.Q = q; r.O = q; r.K = (const bf16_t*)(ws + WS_DK) + (size_t)b * T * 1024 + h * 128; r.V = (const bf16_t*)(ws + WS_DV) + (size_t)b * T * 1024 + h * 128;
    r.MW = (const unsigned long long*)(ws + WS_SEL) + (size_t)b * 256 * T; r.P0 = qb * 256;
    const float slope = exp2f(-(float)(h + 1)); r.slr = slope * 11.313708498984761f;
    const unsigned* ctl = (const unsigned*)(ws + WS_CTL);
    const float q2 = __builtin_bit_cast(float, ctl[CW_NRM + (b * 8 + h) * 2]), k2 = __builtin_bit_cast(float, ctl[CW_NRM + (b * 8 + h) * 2 + 1]);
    const float dextra = (2.f * sqrtf(q2 * k2) * dsa::SCALE * 1.01f + 28.f) / slope + 2.f;
    const float lowest = (float)r.P0 - (float)ctl[CW_DNB + b * 64 + qb] - dextra;
    int jlo = lowest > 0.f ? (int)(lowest * (1.0f / 64.0f)) : 0; if (jlo & 1) jlo -= 1;
    r.jlo = jlo;
    return r;
}
struct DsaNext { unsigned char* ws; volatile int* slot;
    __device__ __forceinline__ dsa::BlockRef operator()(const dsa::BlockRef& cur) const { const int i = __builtin_amdgcn_readfirstlane(*slot); return i < 1024 ? dsa_ref(ws, i) : cur; } };
__device__ __forceinline__ void ph_dsa_attn(const Args& a, char* lds, int bid, int nblk) {
    volatile int* slot = (volatile int*)(lds + dsa::LDS_NEED + 64);
    unsigned* qhead = (unsigned*)(a.ws + WS_CTL) + CW_QHEAD;
    if (threadIdx.x == 0) *slot = (int)__hip_atomic_fetch_add(qhead, 1u, __ATOMIC_RELAXED, __HIP_MEMORY_SCOPE_AGENT);
    __syncthreads();
    int i = __builtin_amdgcn_readfirstlane(*slot); if (i >= 1024) return;
    dsa::BlockRef cur = dsa_ref(a.ws, i);
    dsa::Seam S; dsa::prime(cur, lds, S);
    const DsaNext nf{a.ws, slot};
    for (;;) {
        if (threadIdx.x == 0) *slot = (int)__hip_atomic_fetch_add(qhead, 1u, __ATOMIC_RELAXED, __HIP_MEMORY_SCOPE_AGENT);
        const dsa::BlockRef nxt = dsa::block(cur, nf, lds, S);
        i = __builtin_amdgcn_readfirstlane(*slot);
        __syncthreads();
        if (i >= 1024) break;
        cur = nxt;
    }
}

namespace memat {
constexpr int KB_PITCH = 528, KB_BYTES = 32 * KB_PITCH, VB_PITCH = 72, VB_BYTES = 128 * VB_PITCH;
template <bool MAXP>
__device__ __forceinline__ void pass(LAS unsigned char* Kb, LAS unsigned char* Vb, const bf16_t* kg, const bf16_t* vg, const bf16x8 (&qf)[16], float& mx, float mneg, f32x16 (&o)[4], float& l,
                                     int tid, int r32, int hi) {
    const float c2 = 0.0625f * 1.4426950408889634f;
    const int kkey = tid >> 4, kseg = tid & 15, vd = tid >> 2, vq = tid & 3;
    u32x4 k0 = *(const u32x4*)kg, k1 = *(const u32x4*)(kg + 8), v0 = {0u, 0u, 0u, 0u};
    if (!MAXP) v0 = *(const u32x4*)vg;
    __syncthreads();
    *(LAS u32x4*)(Kb + kkey * KB_PITCH + kseg * 32) = k0; *(LAS u32x4*)(Kb + kkey * KB_PITCH + kseg * 32 + 16) = k1;
    if (!MAXP) { *(LAS u32x2*)(Vb + vd * VB_PITCH + vq * 16) = (u32x2){v0.x, v0.y}; *(LAS u32x2*)(Vb + vd * VB_PITCH + vq * 16 + 8) = (u32x2){v0.z, v0.w}; }
    __syncthreads();
#pragma unroll 1
    for (int mb = 0; mb < 8; ++mb) {
        const int cur = mb & 1, nb = mb + 1 < 8 ? mb + 1 : mb;
        k0 = *(const u32x4*)(kg + (size_t)nb * 32 * 1024); k1 = *(const u32x4*)(kg + (size_t)nb * 32 * 1024 + 8);
        if (!MAXP) v0 = *(const u32x4*)(vg + nb * 32);
        const LAS unsigned char* kb = Kb + cur * KB_BYTES + r32 * KB_PITCH + 16 * hi;
        f32x16 sc;
#pragma unroll
        for (int i = 0; i < 16; ++i) sc[i] = 0.f;
#pragma unroll
        for (int ks = 0; ks < 16; ++ks) { sc = __builtin_amdgcn_mfma_f32_32x32x16_bf16(*(const LAS bf16x8*)(kb + 32 * ks), qf[ks], sc, 0, 0, 0);
            if ((ks & 3) == 3) __builtin_amdgcn_sched_barrier(0); }
        if (MAXP) {
#pragma unroll
            for (int i = 0; i < 16; ++i) mx = fmaxf(mx, sc[i]);
        } else {
#pragma unroll
            for (int i = 0; i < 16; ++i) { sc[i] = __builtin_amdgcn_exp2f(fmaf(sc[i], c2, mneg)); l += sc[i]; }
            const u32x4 w0 = {cvt_pk_bf16(sc[0], sc[1]), cvt_pk_bf16(sc[2], sc[3]), cvt_pk_bf16(sc[4], sc[5]), cvt_pk_bf16(sc[6], sc[7])};
            const u32x4 w1 = {cvt_pk_bf16(sc[8], sc[9]), cvt_pk_bf16(sc[10], sc[11]), cvt_pk_bf16(sc[12], sc[13]), cvt_pk_bf16(sc[14], sc[15])};
            const bf16x8 pa0 = __builtin_bit_cast(bf16x8, w0), pa1 = __builtin_bit_cast(bf16x8, w1);
#pragma unroll
            for (int d0 = 0; d0 < 4; ++d0) { const LAS unsigned char* vp = Vb + cur * VB_BYTES + (d0 * 32 + r32) * VB_PITCH + 8 * hi;
                const u32x2 a0 = *(const LAS u32x2*)vp, a1 = *(const LAS u32x2*)(vp + 16), b0 = *(const LAS u32x2*)(vp + 32), b1 = *(const LAS u32x2*)(vp + 48);
                const u32x4 x0 = {a0.x, a0.y, a1.x, a1.y}, x1 = {b0.x, b0.y, b1.x, b1.y};
                o[d0] = __builtin_amdgcn_mfma_f32_32x32x16_bf16(pa0, __builtin_bit_cast(bf16x8, x0), o[d0], 0, 0, 0);
                o[d0] = __builtin_amdgcn_mfma_f32_32x32x16_bf16(pa1, __builtin_bit_cast(bf16x8, x1), o[d0], 0, 0, 0); } }
        LAS unsigned char* kw = Kb + (cur ^ 1) * KB_BYTES + kkey * KB_PITCH + kseg * 32; *(LAS u32x4*)kw = k0; *(LAS u32x4*)(kw + 16) = k1;
        if (!MAXP) { LAS unsigned char* vw = Vb + (cur ^ 1) * VB_BYTES + vd * VB_PITCH + vq * 16; *(LAS u32x2*)vw = (u32x2){v0.x, v0.y}; *(LAS u32x2*)(vw + 8) = (u32x2){v0.z, v0.w}; }
        __syncthreads();
    }
}
}
__device__ __forceinline__ void ph_mem_attn(const Args& a, LAS unsigned char* lds, int bid, int nblk) {
    unsigned char* ws = a.ws; const int tid = threadIdx.x, lane = tid & 63, wave = __builtin_amdgcn_readfirstlane(tid >> 6), r32 = lane & 31, hi = lane >> 5;
    LAS unsigned char* Kb = lds; LAS unsigned char* Vb = lds + 2 * memat::KB_BYTES; LAS float* linv = (LAS float*)(lds + 2 * memat::KB_BYTES + 2 * memat::VB_BYTES) + wave * 32;
    bf16_t* QDM = (bf16_t*)(ws + WS_QDM); const bf16_t* KM = (const bf16_t*)(ws + WS_KV); const bf16_t* VMT = (const bf16_t*)(ws + WS_KV + MiB);
    for (int grp = bid; grp < (M / 256) * 4; grp += nblk) {
        const int h = grp & 3; const size_t q0 = (size_t)(grp >> 2) * 256 + wave * 32; const int b = (int)(q0 / T);
        bf16x8 qf[16];
#pragma unroll
        for (int ks = 0; ks < 16; ++ks) qf[ks] = *(const bf16x8*)(QDM + (q0 + r32) * 2048 + 1024 + h * 256 + 16 * ks + 8 * hi);
        const bf16_t* kg = KM + ((size_t)b * NMEM + (tid >> 4)) * 1024 + h * 256 + (tid & 15) * 16;
        float mx = -__builtin_inff(), l = 0.f; f32x16 o[4];
        memat::pass<true>(Kb, Vb, kg, nullptr, qf, mx, 0.f, o, l, tid, r32, hi);
        mx = fmaxf(mx, __shfl_xor(mx, 32)); const float mneg = -mx * (0.0625f * 1.4426950408889634f);
#pragma unroll 1
        for (int dh = 0; dh < 2; ++dh) {
            const bf16_t* vg = VMT + ((size_t)b * 1024 + h * 256 + dh * 128 + (tid >> 2)) * 256 + (tid & 3) * 8;
            l = 0.f;
#pragma unroll
            for (int d0 = 0; d0 < 4; ++d0)
#pragma unroll
                for (int i = 0; i < 16; ++i) o[d0][i] = 0.f;
            memat::pass<false>(Kb, Vb, kg, vg, qf, mx, mneg, o, l, tid, r32, hi);
            l += __shfl_xor(l, 32);
            if (hi == 0) linv[r32] = 1.f / l;
            LDS_WAIT(); asm volatile("" ::: "memory");
#pragma unroll
            for (int i = 0; i < 16; ++i) { const int qr = crow(i, hi); const float rl = linv[qr];
#pragma unroll
                for (int d0 = 0; d0 < 4; ++d0) { const float v = o[d0][i] * rl, vn = __shfl_xor(v, 1);
                    if ((r32 & 1) == 0) *(unsigned*)(QDM + (q0 + qr) * 2048 + 1024 + h * 256 + dh * 128 + d0 * 32 + r32) = cvt_pk_bf16(v, vn); } }
            LDS_WAIT(); asm volatile("" ::: "memory");
        }
    }
}

__device__ __forceinline__ void ph_layernorm(float* z, const float* g, const float* bta, unsigned char* xq, int bid, int nblk) {
    const int tid = threadIdx.x, lane = tid & 63, wave = __builtin_amdgcn_readfirstlane(tid >> 6);
    for (int row = bid * 8 + wave; row < M; row += nblk * 8) { float* zr = z + (size_t)row * D;
        f32x4 v[8]; float s = 0.f;
#pragma unroll
        for (int j = 0; j < 8; ++j) { v[j] = *(const f32x4*)(zr + 256 * j + 4 * lane); s += (v[j][0] + v[j][1]) + (v[j][2] + v[j][3]); }
        const float mean = wave_sum(s) * (1.f / D); float s2 = 0.f;
#pragma unroll
        for (int j = 0; j < 8; ++j) { v[j] = v[j] - mean; s2 += (v[j][0] * v[j][0] + v[j][1] * v[j][1]) + (v[j][2] * v[j][2] + v[j][3] * v[j][3]); }
        const float rstd = 1.0f / sqrtf(wave_sum(s2) * (1.f / D) + LN_EPS);
#pragma unroll
        for (int j = 0; j < 8; ++j) { const f32x4 gg = *(const f32x4*)(g + 256 * j + 4 * lane), bb = *(const f32x4*)(bta + 256 * j + 4 * lane); const f32x4 y = v[j] * rstd * gg + bb;
            *(f32x4*)(zr + 256 * j + 4 * lane) = y;
            if (xq) *(unsigned*)(xq + (size_t)row * D + 256 * j + 4 * lane) = pk_fp8x4(y[0], y[1], y[2], y[3]); } }
}

constexpr int NPHASE = 11;
__global__ void __launch_bounds__(512, 2) fwd(Args args) {
    extern __shared__ __attribute__((aligned(16))) unsigned char lds_raw[];
    LAS unsigned char* lds = (LAS unsigned char*)lds_raw;
    unsigned char* ws = args.ws; const int bid = blockIdx.x, nblk = gridDim.x;
    const int lo = args.ph_lo, hi = args.ph_hi;
    volatile LAS unsigned* xbw = (volatile LAS unsigned*)(lds + LDS_BYTES - 16);
    if (threadIdx.x == 0) { xbw[0] = 0u; xbw[1] = 0u; xbw[2] = 0u; xbw[3] = 0u; }
    __syncthreads();
    XcdBarrier bar = xcd_barrier_post((unsigned*)(ws + WS_CTL) + 4096, xbw);
#define GRID_BAR() xcd_barrier(bar)
#define IN(k) (lo <= (k) && (k) < hi)
#define SEAM(k) do { if (IN(k) && IN((k) + 1)) GRID_BAR(); } while (0)
    bf16_t* XB = (bf16_t*)(ws + WS_XB);
    if (IN(0)) { ph_prologue(args, lds, bid, nblk); SEAM(0); }
    if (IN(1)) {
        { pg8::InProjSched S{ws + WS_XQ, ws + WS_W1, 2048, 4096, 16, M / 256, 40, nblk, bid, true}; EpiInProj E{ws, (unsigned char*)args.out, 1.0f / W1_SCALE}; pg8::gemm_phase<true>(lds, S, E); }
        { pg8::InProjSched S{XB, ws + WS_W1, 4096, 4096, 32, M / 256, 5, nblk, bid, false}; EpiInProj E{ws, (unsigned char*)args.out, 1.0f}; pg8::gemm_phase(lds, S, E); }
        { pg8::PlainSched S{ws + WS_MEMB, ws + WS_WMKV, 4096, 4096, 32, 2, 8, nblk, bid}; EpiKV E{(bf16_t*)(ws + WS_KV), (bf16_t*)(ws + WS_KV + MiB)}; pg8::gemm_phase(lds, S, E); }
        SEAM(1);
    }
    if (IN(2)) { ph_dsa_norms(args, lds, bid, nblk); ph_gla_prep(args, lds, bid, nblk); __syncthreads(); ph_dsa_index(args, lds, bid, nblk); __syncthreads();
 ph_mem_attn(args, lds, bid, nblk); SEAM(2); }
    if (IN(3)) { ph_gla_scan(args, lds, bid, nblk); __syncthreads(); ph_dsa_attn(args, (char*)lds_raw, bid, nblk);
        SEAM(3); }
    if (IN(4)) { ph_gla_final(args, bid, nblk);
        { pg8::PlainSched S{ws + WS_XQ, ws + WS_WG, 2048, 2048, 16, M / 256, 24, nblk, bid}; EpiGate E{(bf16_t*)(ws + WS_G), args.in[I_BMERGE]}; pg8::gemm_phase<true>(lds, S, E); }
        SEAM(4); }
    if (IN(5)) { { pg8::MergeSched S{(const unsigned char*)args.out + DO_OGQ, (const unsigned char*)args.out + DO_ODMQ, ws + WS_BRG, ws + WS_BRDM, 2048, 2048, M / 256, 8, nblk, bid};
        EpiMerge E{XB, (const bf16_t*)(ws + WS_G), ws + WS_XQ}; pg8::gemm_phase<true>(lds, S, E); } SEAM(5); }
    if (IN(6)) { { pg8::PlainSched S{ws + WS_XQ, ws + WS_WO, 2048, 2048, 16, M / 256, 8, nblk, bid}; EpiResid E{args.in[I_X], args.out, nullptr, 1.0f / WO_SCALE}; pg8::gemm_phase<true>(lds, S, E); } SEAM(6); }
    if (IN(7)) { ph_layernorm(args.out, args.in[I_LN1G], args.in[I_LN1B], ws + WS_GR, bid, nblk); SEAM(7); }
    if (IN(8)) { { pg8::PlainSched S{ws + WS_GR, ws + WS_WUP, 2048, 2048, 16, M / 256, 32, nblk, bid}; EpiRelu2 E{ws + WS_U, args.in[I_BUP]}; pg8::gemm_phase<true>(lds, S, E); } SEAM(8); }
    if (IN(9)) { pg8::PlainSched S{ws + WS_U, ws + WS_WDOWN, 8192, 8192, 64, M / 256, 8, nblk, bid}; EpiResid E{args.out, args.out, args.in[I_BDOWN], 1.0f / WD_SCALE}; pg8::gemm_phase<true>(lds, S, E); SEAM(9); }
    if (IN(10)) { ph_layernorm(args.out, args.in[I_LN2G], args.in[I_LN2B], nullptr, bid, nblk); }
#undef IN
#undef SEAM
}

extern "C" void kernel_launch(void* const* d_in, const int* in_sizes, int n_in, void* d_out, int out_size, void* d_ws, size_t ws_size, hipStream_t stream) {
    static int grid = 0;
    if (grid == 0) {
        if (n_in != 20 || out_size != M * D || ws_size < WS_END) { fprintf(stderr, "kernel_launch: unexpected shapes (n_in %d, out %d, ws %zu)\n", n_in, out_size, ws_size); grid = -1; return; }
        int dev = 0, cus = 0;
        if (hipGetDevice(&dev) != hipSuccess || hipDeviceGetAttribute(&cus, hipDeviceAttributeMultiprocessorCount, dev) != hipSuccess) { grid = -1; return; }
        if (hipFuncSetAttribute((const void*)fwd, hipFuncAttributeMaxDynamicSharedMemorySize, LDS_BYTES) != hipSuccess) { grid = -1; return; }
        int per_cu = 0;
        if (hipOccupancyMaxActiveBlocksPerMultiprocessor(&per_cu, (const void*)fwd, 512, LDS_BYTES) != hipSuccess || per_cu < 1) { fprintf(stderr, "kernel_launch: occupancy query says %d\n", per_cu); }
        (void)hipGetLastError();
        grid = cus;
    }
    if (grid < 0) return;
    (void)hipMemsetAsync((char*)d_ws + WS_CTL, 0, CTL_ZERO_BYTES, stream);
    Args a{};
    for (int i = 0; i < 20; ++i) a.in[i] = (const float*)d_in[i];
    a.out = (float*)d_out; a.ws = (unsigned char*)d_ws;
    a.ph_lo = 0; a.ph_hi = NPHASE;
    hipLaunchKernelGGL(fwd, dim3(grid), dim3(512), LDS_BYTES, stream, a);
}
```
